# Optimizing an MI355X kernel written in HIP

```python
import jax, jax.numpy as jnp
from jax import lax
import numpy as np

D_MODEL = 4096
BATCH = 4
SEQ = 4096
DEPTH = 4

BLOCK = 128
RMS_EPS = 1e-6
HEAD_DIM_AB = 128
A_PAIRS = ((128, 1), (512, 4), (2048, 16))
A_HEADS_PER_GROUP = D_MODEL // 512
A_HEADS = A_HEADS_PER_GROUP * len(A_PAIRS)
B_HEADS = D_MODEL // 512
A_HW = A_HEADS * HEAD_DIM_AB
B_HW = B_HEADS * HEAD_DIM_AB
AB_IN = 3 * A_HW + 3 * B_HW
AB_OUT = (A_HEADS_PER_GROUP + B_HEADS) * HEAD_DIM_AB
C_HEAD_DIM = 64
C_Q_HEADS = D_MODEL // C_HEAD_DIM
C_KV_HEADS = 8
C_WINDOW = 128
C_IN = (C_Q_HEADS + 2 * C_KV_HEADS) * C_HEAD_DIM
C_OUT = C_Q_HEADS * C_HEAD_DIM
D_FF = 3 * D_MODEL // 2
N_EVEN = (DEPTH + 1) // 2
N_ODD = DEPTH // 2

kernel_name = "hybrid_dilated_stickbreak_swa_macaron"


def alibi_slopes(n):
    return jnp.asarray(2.0 ** (-8.0 * np.arange(1, n + 1) / n), dtype=jnp.float32)


def rms_norm(x, g):
    xf = x.astype(jnp.float32)
    y = xf * lax.rsqrt(jnp.mean(xf * xf, axis=-1, keepdims=True) + RMS_EPS)
    return (y * g.astype(jnp.float32)).astype(x.dtype)


def swiglu(x, w_in, w_out):
    gate, up = jnp.split(x @ w_in, 2, axis=-1)
    return (jax.nn.silu(gate) * up) @ w_out


def banded_attention(q, k, v, max_dist, slopes, dist_scale, sinks=None):
    N, L, H, hd = q.shape
    Hkv = k.shape[2]
    G = H // Hkv
    nb = -(-L // BLOCK)
    Lp = nb * BLOCK
    padw = ((0, 0), (0, Lp - L), (0, 0), (0, 0))
    qb = jnp.pad(q, padw).reshape(N, nb, BLOCK, Hkv, G, hd)
    kb = jnp.pad(k, padw).reshape(N, nb, BLOCK, Hkv, hd)
    vb = jnp.pad(v, padw).reshape(N, nb, BLOCK, Hkv, hd)
    kcat = jnp.concatenate([jnp.concatenate([jnp.zeros_like(kb[:, :1]), kb[:, :-1]], axis=1), kb], axis=2)
    vcat = jnp.concatenate([jnp.concatenate([jnp.zeros_like(vb[:, :1]), vb[:, :-1]], axis=1), vb], axis=2)
    s = jnp.einsum('nbqkgd,nbskd->nbkgqs', qb, kcat).astype(jnp.float32) * (hd ** -0.5)
    qi = jnp.arange(BLOCK)[:, None]
    si = jnp.arange(2 * BLOCK)[None, :]
    dist = qi - si + BLOCK
    key_pos = jnp.arange(nb)[:, None, None] * BLOCK - BLOCK + si[None]
    valid = (dist >= 0) & (dist <= max_dist) & (key_pos >= 0)
    bias = -(slopes.reshape(Hkv, G)[:, :, None, None] * (dist_scale * dist.astype(jnp.float32)))
    s = jnp.where(valid[None, :, None, None], s + bias, -jnp.inf)
    m = jnp.max(s, axis=-1)
    if sinks is not None:
        sk = sinks.astype(jnp.float32).reshape(Hkv, G)[:, :, None]
        m = jnp.maximum(m, sk)
    p = jnp.exp(s - m[..., None])
    denom = jnp.sum(p, axis=-1)
    if sinks is not None:
        denom = denom + jnp.exp(sk - m)
    o = jnp.einsum('nbkgqs,nbskd->nbqkgd', p, vcat.astype(jnp.float32))
    o = o / jnp.transpose(denom, (0, 1, 4, 2, 3))[..., None]
    lse = jnp.transpose(m + jnp.log(denom), (0, 1, 4, 2, 3)).reshape(N, Lp, H)
    return o.reshape(N, Lp, H, hd)[:, :L].astype(q.dtype), lse[:, :L]


def dilate(t, r):
    B, S = t.shape[:2]
    rest = t.shape[2:]
    return t.reshape((B, S // r, r) + rest).swapaxes(1, 2).reshape((B * r, S // r) + rest)


def undilate(t, r, B):
    L = t.shape[1]
    rest = t.shape[2:]
    return t.reshape((B, r, L) + rest).swapaxes(1, 2).reshape((B, r * L) + rest)


def stick_breaking(q, k, v):
    B, S, H, hd = q.shape
    outs = []
    for b in range(S // BLOCK):
        e = (b + 1) * BLOCK
        z = jnp.einsum('bqhd,bshd->bhqs', q[:, b * BLOCK:e], k[:, :e]).astype(jnp.float32) * (hd ** -0.5)
        causal = jnp.arange(e)[None, :] < (b * BLOCK + jnp.arange(BLOCK))[:, None]
        log_keep = jnp.where(causal, jax.nn.log_sigmoid(-z), 0.0)
        after = lax.cumsum(log_keep, axis=3, reverse=True) - log_keep
        a = jnp.where(causal, jnp.exp(jax.nn.log_sigmoid(z) + after), 0.0)
        outs.append(jnp.einsum('bhqs,bshd->bqhd', a, v[:, :e].astype(jnp.float32)))
    return jnp.concatenate(outs, axis=1).astype(q.dtype)


def mixer_ab(h, w_in, w_out):
    B, S, _ = h.shape
    cuts = [A_HW, 2 * A_HW, 3 * A_HW, 3 * A_HW + B_HW, 3 * A_HW + 2 * B_HW]
    qa, ka, va, qb, kb, vb = jnp.split(h @ w_in, cuts, axis=-1)
    qa, ka, va = (t.reshape(B, S, A_HEADS, HEAD_DIM_AB) for t in (qa, ka, va))
    qb, kb, vb = (t.reshape(B, S, B_HEADS, HEAD_DIM_AB) for t in (qb, kb, vb))
    slopes = alibi_slopes(A_HEADS)
    outs, lses = [], []
    for gi, (window, r) in enumerate(A_PAIRS):
        sl = slice(gi * A_HEADS_PER_GROUP, (gi + 1) * A_HEADS_PER_GROUP)
        o, l = banded_attention(dilate(qa[:, :, sl], r), dilate(ka[:, :, sl], r), dilate(va[:, :, sl], r),
                                window // r, slopes[sl], r)
        outs.append(undilate(o, r, B))
        lses.append(undilate(l, r, B))
    wts = jax.nn.softmax(jnp.stack(lses), axis=0)
    out_a = jnp.sum(wts[..., None] * jnp.stack(outs).astype(jnp.float32), axis=0).astype(h.dtype)
    out_b = stick_breaking(qb, kb, vb)
    cat = jnp.concatenate([out_a.reshape(B, S, -1), out_b.reshape(B, S, -1)], axis=-1)
    return cat @ w_out


def mixer_c(h, w_in, w_out, sinks):
    B, S, _ = h.shape
    kvw = C_KV_HEADS * C_HEAD_DIM
    q, k, v = jnp.split(h @ w_in, [C_OUT, C_OUT + kvw], axis=-1)
    q = q.reshape(B, S, C_Q_HEADS, C_HEAD_DIM)
    k = k.reshape(B, S, C_KV_HEADS, C_HEAD_DIM)
    v = v.reshape(B, S, C_KV_HEADS, C_HEAD_DIM)
    o, _ = banded_attention(q, k, v, C_WINDOW - 1, alibi_slopes(C_Q_HEADS), 1.0, sinks)
    return o.reshape(B, S, C_OUT) @ w_out


def setup_inputs(seed: int = 0) -> dict:
    key = jax.random.key(seed)
    ks = jax.random.split(key, 16)
    f32 = jnp.float32

    def w(k, shape, fan_in):
        return jax.random.normal(k, shape, f32) * (fan_in ** -0.5)

    def gain(k, shape):
        return 1.0 + 0.01 * jax.random.normal(k, shape, f32)

    return {
        "x": jax.random.normal(ks[0], (BATCH, SEQ, D_MODEL), f32),
        "ffn1_norm": gain(ks[1], (DEPTH, D_MODEL)),
        "ffn1_w_in": w(ks[2], (DEPTH, D_MODEL, 2 * D_FF), D_MODEL),
        "ffn1_w_out": w(ks[3], (DEPTH, D_FF, D_MODEL), D_FF),
        "mix_norm": gain(ks[4], (DEPTH, D_MODEL)),
        "ab_w_in": w(ks[5], (N_EVEN, D_MODEL, AB_IN), D_MODEL),
        "ab_w_out": w(ks[6], (N_EVEN, AB_OUT, D_MODEL), AB_OUT),
        "c_w_in": w(ks[7], (N_ODD, D_MODEL, C_IN), D_MODEL),
        "c_w_out": w(ks[8], (N_ODD, C_OUT, D_MODEL), C_OUT),
        "c_sinks": 0.5 * jax.random.normal(ks[9], (N_ODD, C_Q_HEADS), f32),
        "ffn2_norm": gain(ks[10], (DEPTH, D_MODEL)),
        "ffn2_w_in": w(ks[11], (DEPTH, D_MODEL, 2 * D_FF), D_MODEL),
        "ffn2_w_out": w(ks[12], (DEPTH, D_FF, D_MODEL), D_FF),
        "final_norm": gain(ks[13], (D_MODEL,)),
    }


def reference(x, ffn1_norm, ffn1_w_in, ffn1_w_out, mix_norm, ab_w_in, ab_w_out, c_w_in, c_w_out,
              c_sinks, ffn2_norm, ffn2_w_in, ffn2_w_out, final_norm):
    for l in range(DEPTH):
        x = x + 0.5 * swiglu(rms_norm(x, ffn1_norm[l]), ffn1_w_in[l], ffn1_w_out[l])
        h = rms_norm(x, mix_norm[l])
        if l % 2 == 0:
            x = x + mixer_ab(h, ab_w_in[l // 2], ab_w_out[l // 2])
        else:
            x = x + mixer_c(h, c_w_in[l // 2], c_w_out[l // 2], c_sinks[l // 2])
        x = x + 0.5 * swiglu(rms_norm(x, ffn2_norm[l]), ffn2_w_in[l], ffn2_w_out[l])
    return rms_norm(x, final_norm)
```

```cpp
#include <hip/hip_runtime.h>
#include <cstdio>
#include <cstdint>

namespace pg8 {
#define PG8_LAS __attribute__((address_space(3)))
typedef unsigned short bf16_t;
typedef short bf16x8 __attribute__((ext_vector_type(8)));
typedef float f32x4 __attribute__((ext_vector_type(4)));
typedef unsigned u32x4 __attribute__((ext_vector_type(4)));
constexpr int BM = 256, BK = 64, HALF = 128, HTB = HALF * BK * 2  , STAGE_BYTES = 8 * HTB, NXCD = 8, WGM = 8;

__host__ __device__ __forceinline__ int lds_byte(int r, int c) { const int st = (r >> 4) * 2 + (c >> 5), rr = r & 15, cc = c & 31, ob = rr * 64 + cc * 2; return st * 1024 + (ob ^ (((ob >> 9) & 1) << 5)); }
__host__ __device__ __forceinline__ void stage_rc(int b, int& R, int& C) { const int st = b / 1024, sb = b % 1024, swz = sb ^ (((sb >> 9) & 1) << 5); R = (st >> 1) * 16 + swz / 64; C = (st & 1) * 32 + (swz % 64) / 2; }
__host__ __device__ __forceinline__ int perm32(int rho) { const int n = rho >> 4, i = rho & 15; return 8 * (i >> 2) + 4 * n + (i & 3); }

struct Unit { int pm, pn; };
struct Gemm { const bf16_t* A; const bf16_t* Bt; int M, N, K; };

struct StaticOrder {
    int nM, nN, nwg, G, c, wave;
    __host__ __device__ void init(int M, int N, int G_, int c_, int wave_ = 0) { nM = M / BM; nN = N / BM; nwg = nM * nN; G = G_; c = c_; wave = wave_; }
    __host__ __device__ bool next(int i, Unit& u) const {
        const long L = (long)i * G + c; if (L >= nwg) return false;
        int wgid = (int)L; { const int q = nwg / NXCD, r = nwg % NXCD, xcd = wgid % NXCD, off = wgid / NXCD; wgid = (xcd < r ? xcd * (q + 1) : r * (q + 1) + (xcd - r) * q) + off; }
        const int nig = WGM * nN, gid = wgid / nig, fm = gid * WGM, gsz = (nM - fm) < WGM ? (nM - fm) : WGM;
        u.pm = fm + ((wgid % nig) % gsz); u.pn = (wgid % nig) / gsz; return true;
    }
    __device__ __forceinline__ void a_ready(const Unit&) const {}
    __device__ __forceinline__ void done(const Unit&) const {}
};

struct GroupOrder {
    int nU, mode8, pm0, pnb, wave;
    __host__ __device__ void init(int N, int base, int cl, int wave_) { const int nN = N / BM; nU = nN / 4; mode8 = (nN % 8 == 0); pm0 = base + (mode8 ? (cl & 3) : (cl & 7)); pnb = mode8 ? (cl >> 2) : (cl >> 3); wave = wave_; }
    __device__ __forceinline__ bool next(int i, Unit& u) const { if (i >= nU) return false; int p = mode8 ? pm0 + 4 * (i & 1) : pm0; asm volatile("" : "+s"(p)); u.pm = p; u.pn = mode8 ? 8 * (i >> 1) + pnb : 4 * i + pnb; return true; }
    __device__ __forceinline__ void a_ready(const Unit&) const {}
    __device__ __forceinline__ void done(const Unit&) const {}
};

__device__ __forceinline__ unsigned cvt_pk_bf16(float lo, float hi) { unsigned r; asm volatile("v_cvt_pk_bf16_f32 %0, %1, %2" : "=v"(r) : "v"(lo), "v"(hi)); return r; }

typedef float f32x2 __attribute__((ext_vector_type(2)));
__device__ __forceinline__ float silu_f(float g) { return g * __builtin_amdgcn_rcpf(1.0f + __builtin_amdgcn_exp2f(-1.44269504089f * g)); }
constexpr float K_NORM_INV = 1.0f / 4096.0f, K_NORM_EPS = 1e-6f;
constexpr int NPART = 64;
struct RowScale {
    PG8_LAS const float* tab; int pm0; const float* part;
    __device__ __forceinline__ float get(int pm, int r  ) const { return tab[(pm != pm0 ? 256 : 0) + r]; }
};
__device__ __forceinline__ void rinv_panel(const float* part, int pm, PG8_LAS float* tab, int wave) {
    const int tid = wave * 64 + (int)__builtin_amdgcn_mbcnt_hi(~0u, __builtin_amdgcn_mbcnt_lo(~0u, 0u));
    const int r = tid >> 1, hf = tid & 1; const f32x4* p = (const f32x4*)(part + (size_t)(pm * BM + r) * NPART + hf * 32);
    f32x4 a = p[0];
#pragma unroll
    for (int i = 1; i < 8; ++i) a += p[i];
    float sm = (a[0] + a[1]) + (a[2] + a[3]); sm += __shfl_xor(sm, 1);
    if (hf == 0) tab[r] = __builtin_amdgcn_rsqf(sm * K_NORM_INV + K_NORM_EPS);
    __syncthreads();
}
template <int HD> struct EpiHeads {
    static constexpr bool PERM = true, AFTER_DRAIN = false;
    bf16_t* O; int mtot; RowScale rsc;
    __device__ __forceinline__ void operator()(const f32x4 (&acc)[2][2][4][2], const Unit& u, int wr, int wc, int fr, int fq) const {
        const int row0 = u.pm * BM + wr * 64 + fr;
#pragma unroll
        for (int ai = 0; ai < 2; ++ai)
#pragma unroll
            for (int m = 0; m < 4; ++m) { const int row = row0 + ai * HALF + m * 16; const float ri = rsc.get(u.pm, row - u.pm * BM);
#pragma unroll
                for (int bj = 0; bj < 2; ++bj) { const f32x4 v0 = acc[ai][bj][m][0] * ri, v1 = acc[ai][bj][m][1] * ri;
                    const int tcol = bj * HALF + wc * 32 + 8 * fq;
                    const int head = u.pn * (BM / HD) + tcol / HD, hcol = tcol % HD;
                    u32x4 w; w.x = cvt_pk_bf16(v0[0], v0[1]); w.y = cvt_pk_bf16(v0[2], v0[3]); w.z = cvt_pk_bf16(v1[0], v1[1]); w.w = cvt_pk_bf16(v1[2], v1[3]);
                    *(u32x4*)(O + ((size_t)head * mtot + row) * HD + hcol) = w; } }
    }
};
struct EpiSwiglu {
    static constexpr bool PERM = true, AFTER_DRAIN = false;
    bf16_t* O; int ldc; RowScale rsc;
    __device__ __forceinline__ void operator()(const f32x4 (&acc)[2][2][4][2], const Unit& u, int wr, int wc, int fr, int fq) const {
        const int row0 = u.pm * BM + wr * 64 + fr, col0 = u.pn * HALF + wc * 32 + 8 * fq;
#pragma unroll
        for (int ai = 0; ai < 2; ++ai)
#pragma unroll
            for (int m = 0; m < 4; ++m) { const int row = row0 + ai * HALF + m * 16; bf16_t* rowp = O + (size_t)row * ldc + col0; const float ri = rsc.get(u.pm, row - u.pm * BM);
                const float na = ri * -1.44269504089f, ri2 = ri * ri;
                const f32x4 g0 = acc[ai][0][m][0], g1 = acc[ai][0][m][1], u0 = acc[ai][1][m][0], u1 = acc[ai][1][m][1];
                f32x4 t0 = g0 * na, t1 = g1 * na;
#pragma unroll
                for (int j = 0; j < 4; ++j) { t0[j] = __builtin_amdgcn_exp2f(t0[j]); t1[j] = __builtin_amdgcn_exp2f(t1[j]); }
                t0 = t0 + 1.0f; t1 = t1 + 1.0f;
#pragma unroll
                for (int j = 0; j < 4; ++j) { t0[j] = __builtin_amdgcn_rcpf(t0[j]); t1[j] = __builtin_amdgcn_rcpf(t1[j]); }
                const f32x4 h0 = (g0 * u0) * ri2 * t0, h1 = (g1 * u1) * ri2 * t1;
                u32x4 w; w.x = cvt_pk_bf16(h0[0], h0[1]); w.y = cvt_pk_bf16(h0[2], h0[3]); w.z = cvt_pk_bf16(h1[0], h1[1]); w.w = cvt_pk_bf16(h1[2], h1[3]);
                *(u32x4*)rowp = w; }
    }
};
struct EpiResid {
    static constexpr bool PERM = true, AFTER_DRAIN = false;
    bf16_t* xb; float* part; int ldc; float scale;
    __device__ __forceinline__ void operator()(const f32x4 (&acc)[2][2][4][2], const Unit& u, int wr, int wc, int fr, int fq) const {
        const int row0 = u.pm * BM + wr * 64 + fr, col0 = u.pn * BM + wc * 32 + 8 * fq;
#pragma unroll
        for (int ai = 0; ai < 2; ++ai) {
        u32x4 bs[4][2];
#pragma unroll
            for (int m = 0; m < 4; ++m) { const size_t off = (size_t)(row0 + ai * HALF + m * 16) * ldc + col0;
#pragma unroll
                for (int bj = 0; bj < 2; ++bj) bs[m][bj] = *(const u32x4*)(xb + off + bj * HALF); }
#pragma unroll
            for (int m = 0; m < 4; ++m) { const int row = row0 + ai * HALF + m * 16; const size_t off = (size_t)row * ldc + col0; float ss = 0.f;
#pragma unroll
                for (int bj = 0; bj < 2; ++bj) { const u32x4 b = bs[m][bj]; f32x4 v0, v1;
                    v0[0] = __builtin_bit_cast(float, b.x << 16); v0[1] = __builtin_bit_cast(float, b.x & 0xffff0000u); v0[2] = __builtin_bit_cast(float, b.y << 16); v0[3] = __builtin_bit_cast(float, b.y & 0xffff0000u);
                    v1[0] = __builtin_bit_cast(float, b.z << 16); v1[1] = __builtin_bit_cast(float, b.z & 0xffff0000u); v1[2] = __builtin_bit_cast(float, b.w << 16); v1[3] = __builtin_bit_cast(float, b.w & 0xffff0000u);
                    v0 = v0 + acc[ai][bj][m][0] * scale; v1 = v1 + acc[ai][bj][m][1] * scale;
                    u32x4 w; w.x = cvt_pk_bf16(v0[0], v0[1]); w.y = cvt_pk_bf16(v0[2], v0[3]); w.z = cvt_pk_bf16(v1[0], v1[1]); w.w = cvt_pk_bf16(v1[2], v1[3]);
                    *(u32x4*)(xb + off + bj * HALF) = w;
                    ss += (v0[0] * v0[0] + v0[1] * v0[1]) + (v0[2] * v0[2] + v0[3] * v0[3]) + (v1[0] * v1[0] + v1[1] * v1[1]) + (v1[2] * v1[2] + v1[3] * v1[3]); }
                ss += __shfl_xor(ss, 16); ss += __shfl_xor(ss, 32);
                if (fq == 0) part[(size_t)row * NPART + u.pn * 4 + wc] = ss; }
            asm volatile("" ::: "memory"); }
    }
};


template <class Epi, class Sched, bool ALIGN_EPI = false, bool SP2 = false>
__device__ __forceinline__ void gemm_phase(PG8_LAS unsigned char* lds, const Gemm g, const Sched& S, const Epi& E) {
    int lane_l = (int)__builtin_amdgcn_mbcnt_hi(~0u, __builtin_amdgcn_mbcnt_lo(~0u, 0u)); asm volatile("" : "+v"(lane_l));
    const int wid = __builtin_amdgcn_readfirstlane(S.wave), lane = lane_l, tid = wid * 64 + lane, wr = wid >> 2, wc = wid & 3, fr = lane & 15, fq = lane >> 4;
    const int K = g.K, nt = K / BK;
    unsigned voffA[2], voffB[2];
#pragma unroll
    for (int i = 0; i < 2; ++i) { int R, C; stage_rc(tid * 16 + i * 8192, R, C); const int Rb = Epi::PERM ? ((R & ~31) + perm32(R & 31)) : R;
        voffA[i] = (unsigned)(R * K + C) * 2u; voffB[i] = (unsigned)(Rb * K + C) * 2u; }
    const size_t kstep = (size_t)(BK * 2);
    const size_t hstep = (size_t)HALF * K * 2;
    const size_t tstep = 2 * hstep;
    const unsigned ldsw = (unsigned)wid * 1024u;
    const int aoff = lds_byte(wr * 64 + fr, fq * 8), boff = lds_byte(wc * 32 + fr, fq * 8);
#define PG8_SA(b, h) (((b) * 2 + (h)) * HTB)
#define PG8_SB(b, h) ((4 + (b) * 2 + (h)) * HTB)
#define PG8_STAGE(bufoff, gbase, voff) do { _Pragma("unroll") for (int _i = 0; _i < 2; ++_i) \
        __builtin_amdgcn_global_load_lds((const unsigned*)((const char*)(gbase) + (voff)[_i]), (PG8_LAS unsigned*)(lds + (bufoff) + ldsw + _i * 8192), 16, 0, 0); } while (0)
#define PG8_LDA(dst, b, h) do { _Pragma("unroll") for (int m = 0; m < 4; ++m) _Pragma("unroll") for (int k = 0; k < 2; ++k) dst[m][k] = *(const PG8_LAS bf16x8*)(lds + PG8_SA(b, h) + aoff + m * 2048 + k * 1024); } while (0)
#define PG8_LDB(dst, b, h) do { _Pragma("unroll") for (int n = 0; n < 2; ++n) _Pragma("unroll") for (int k = 0; k < 2; ++k) dst[n][k] = *(const PG8_LAS bf16x8*)(lds + PG8_SB(b, h) + boff + n * 2048 + k * 1024); } while (0)
#define PG8_MMA(ai, bj, At, Bt) do { __builtin_amdgcn_s_setprio(1); _Pragma("unroll") for (int m = 0; m < 4; ++m) _Pragma("unroll") for (int n = 0; n < 2; ++n) _Pragma("unroll") for (int k = 0; k < 2; ++k) \
        acc[ai][bj][m][n] = __builtin_amdgcn_mfma_f32_16x16x32_bf16(Bt[n][k], At[m][k], acc[ai][bj][m][n], 0, 0, 0); __builtin_amdgcn_s_setprio(0); } while (0)
#define PG8_WAIT_V(n) asm volatile("s_waitcnt vmcnt(" #n ")" ::: "memory")
#define PG8_WAIT_L(n) asm volatile("s_waitcnt lgkmcnt(" #n ")" ::: "memory")
#define PG8_BAR __builtin_amdgcn_s_barrier()
#define PG8_SCHED __builtin_amdgcn_sched_barrier(0)
    Unit cur, nxt; int ui = 0;
    if (!S.next(0, cur)) return;
    f32x4 acc[2][2][4][2];
#pragma unroll
    for (int a = 0; a < 2; ++a)
#pragma unroll
        for (int b = 0; b < 2; ++b)
#pragma unroll
            for (int m = 0; m < 4; ++m)
#pragma unroll
                for (int n = 0; n < 2; ++n) acc[a][b][m][n] = (f32x4){0.f, 0.f, 0.f, 0.f};
    bf16x8 At[4][2], B0[2][2], B1[2][2];
    const char* cA = (const char*)g.A + (size_t)cur.pm * tstep; const char* cB = (const char*)g.Bt + (size_t)cur.pn * tstep;
    S.a_ready(cur);
    if constexpr (SP2) {
        PG8_STAGE(PG8_SB(0, 0), cB, voffB); PG8_STAGE(PG8_SB(0, 1), cB + hstep, voffB); PG8_STAGE(PG8_SA(0, 0), cA, voffA); PG8_STAGE(PG8_SA(0, 1), cA + hstep, voffA);
        if (wr == 1) PG8_BAR;
        PG8_WAIT_V(2); PG8_BAR;
        PG8_STAGE(PG8_SB(1, 0), cB + kstep, voffB); PG8_STAGE(PG8_SA(1, 0), cA + kstep, voffA); PG8_STAGE(PG8_SB(1, 1), cB + hstep + kstep, voffB);
        PG8_WAIT_V(6); PG8_BAR;
    } else {
        PG8_STAGE(PG8_SB(0, 0), cB, voffB); PG8_STAGE(PG8_SA(0, 0), cA, voffA); PG8_STAGE(PG8_SB(0, 1), cB + hstep, voffB); PG8_STAGE(PG8_SA(0, 1), cA + hstep, voffA);
        if (wr == 1) PG8_BAR;
        PG8_WAIT_V(4); PG8_BAR;
        PG8_STAGE(PG8_SB(1, 0), cB + kstep, voffB); PG8_STAGE(PG8_SA(1, 0), cA + kstep, voffA); PG8_STAGE(PG8_SB(1, 1), cB + hstep + kstep, voffB);
        PG8_WAIT_V(6); PG8_BAR;
    }
    for (;;) {
        const bool has_next = S.next(ui + 1, nxt);
        const char* nA = has_next ? (const char*)g.A + (size_t)nxt.pm * tstep : cA; const char* nB = has_next ? (const char*)g.Bt + (size_t)nxt.pn * tstep : cB;
        for (int t = 0; t < nt; t += 2) {
            const bool last = (t == nt - 2);
            const char* a1 = cA + (size_t)(t + 1) * kstep;
            const char* a2 = last ? nA : cA + (size_t)(t + 2) * kstep; const char* b2 = last ? nB : cB + (size_t)(t + 2) * kstep;
            const char* a3 = a2 + kstep; const char* b3 = b2 + kstep;
            if (last && has_next) S.a_ready(nxt);
            if constexpr (SP2) {
            PG8_LDB(B0, 0, 0); PG8_LDB(B1, 0, 1); PG8_SCHED; PG8_LDA(At, 0, 0); PG8_STAGE(PG8_SA(1, 1), a1 + hstep, voffA);
            PG8_WAIT_V(8); PG8_WAIT_L(0); PG8_BAR; PG8_MMA(0, 0, At, B0); PG8_MMA(0, 1, At, B1); PG8_BAR; PG8_SCHED;
            PG8_LDA(At, 0, 1); PG8_STAGE(PG8_SB(0, 0), b2, voffB); PG8_STAGE(PG8_SB(0, 1), b2 + hstep, voffB); PG8_STAGE(PG8_SA(0, 0), a2, voffA);
            PG8_WAIT_V(8); PG8_WAIT_L(0); PG8_BAR; PG8_MMA(1, 0, At, B0); PG8_MMA(1, 1, At, B1); PG8_BAR; PG8_SCHED;
            PG8_LDB(B0, 1, 0); PG8_LDB(B1, 1, 1); PG8_SCHED; PG8_LDA(At, 1, 0); PG8_STAGE(PG8_SA(0, 1), a2 + hstep, voffA);
            PG8_WAIT_V(8); PG8_WAIT_L(0); PG8_BAR; PG8_MMA(0, 0, At, B0); PG8_MMA(0, 1, At, B1); PG8_BAR; PG8_SCHED;
            PG8_LDA(At, 1, 1); PG8_STAGE(PG8_SB(1, 0), b3, voffB); PG8_STAGE(PG8_SB(1, 1), b3 + hstep, voffB); PG8_STAGE(PG8_SA(1, 0), a3, voffA);
            PG8_WAIT_V(8); PG8_WAIT_L(0); PG8_BAR; PG8_MMA(1, 0, At, B0); PG8_MMA(1, 1, At, B1); PG8_BAR; PG8_SCHED;
            } else {
            PG8_LDB(B0, 0, 0); PG8_SCHED; PG8_LDA(At, 0, 0); PG8_STAGE(PG8_SA(1, 1), a1 + hstep, voffA);
            PG8_WAIT_L(8); PG8_BAR; PG8_WAIT_L(0); PG8_MMA(0, 0, At, B0); PG8_BAR; PG8_SCHED;
            PG8_LDB(B1, 0, 1); PG8_STAGE(PG8_SB(0, 0), b2, voffB);
            PG8_BAR; PG8_WAIT_L(0); PG8_MMA(0, 1, At, B1); PG8_BAR;
            PG8_LDA(At, 0, 1); PG8_STAGE(PG8_SA(0, 0), a2, voffA);
            PG8_BAR; PG8_WAIT_L(0); PG8_MMA(1, 0, At, B0); PG8_BAR; PG8_SCHED;
            PG8_STAGE(PG8_SB(0, 1), b2 + hstep, voffB);
            PG8_WAIT_V(6); PG8_BAR; PG8_MMA(1, 1, At, B1); PG8_BAR;
            PG8_LDB(B0, 1, 0); PG8_SCHED; PG8_LDA(At, 1, 0); PG8_STAGE(PG8_SA(0, 1), a2 + hstep, voffA);
            PG8_WAIT_L(8); PG8_BAR; PG8_WAIT_L(0); PG8_MMA(0, 0, At, B0); PG8_BAR; PG8_SCHED;
            PG8_LDB(B1, 1, 1); PG8_STAGE(PG8_SB(1, 0), b3, voffB);
            PG8_BAR; PG8_WAIT_L(0); PG8_MMA(0, 1, At, B1); PG8_BAR;
            PG8_LDA(At, 1, 1); PG8_STAGE(PG8_SA(1, 0), a3, voffA);
            PG8_BAR; PG8_WAIT_L(0); PG8_MMA(1, 0, At, B0); PG8_BAR; PG8_SCHED;
            PG8_STAGE(PG8_SB(1, 1), b3 + hstep, voffB);
            PG8_WAIT_V(6); PG8_BAR; PG8_MMA(1, 1, At, B1); PG8_BAR;
            }
        }
        if constexpr (ALIGN_EPI) { if (wr == 0) PG8_BAR; }
        if constexpr (!Epi::AFTER_DRAIN) { E(acc, cur, wr, wc, fr, fq); S.done(cur); }
        if (!has_next) break;
#pragma unroll
        for (int a = 0; a < 2; ++a)
#pragma unroll
            for (int b = 0; b < 2; ++b)
#pragma unroll
                for (int m = 0; m < 4; ++m)
#pragma unroll
                    for (int n = 0; n < 2; ++n) acc[a][b][m][n] = (f32x4){0.f, 0.f, 0.f, 0.f};
        cur = nxt; cA = nA; cB = nB; ++ui;
        if constexpr (ALIGN_EPI) { if (wr == 1) PG8_BAR; }
    }
    PG8_WAIT_V(0);
    if constexpr (!ALIGN_EPI) { if (wr == 0) PG8_BAR; }
    PG8_BAR;
    if constexpr (Epi::AFTER_DRAIN) { E.fused(acc, cur, wr, wc, fr, fq, lds, wid, lane); S.done(cur); }
#undef PG8_SA
#undef PG8_SB
#undef PG8_STAGE
#undef PG8_LDA
#undef PG8_LDB
#undef PG8_MMA
#undef PG8_WAIT_V
#undef PG8_WAIT_L
#undef PG8_BAR
#undef PG8_SCHED
}
}

#ifndef PG8_SP2
#define PG8_SP2 true
#endif
#ifndef PG8_ALIGN
#define PG8_ALIGN true
#endif
#ifndef PROBE_DUP
#define PROBE_DUP 0
#endif
#ifndef MK_PER_PHASE
#define MK_PER_PHASE 0
#endif

constexpr int NWAVES = 8;
constexpr int BATCH = 4, SEQ = 4096, D = 4096, DEPTH = 4, M = BATCH * SEQ;
constexpr int DFF = 6144, AB_IN = 12288, AB_OUT = 2048, C_IN = 5120, C_OUT = 4096;
constexpr float RMS_EPS = 1e-6f;
constexpr int N_PHASES = 1 + 8 * 3 + 4 * 3 + 1;

constexpr size_t MiB = 1u << 20;
constexpr size_t WS_CTL = 0, CTL_ZERO_BYTES = 1 * MiB;
constexpr size_t WS_WFFI = 1 * MiB;
constexpr size_t WS_WFFO = WS_WFFI + 8 * 96 * MiB;
constexpr size_t WS_WABI = WS_WFFO + 8 * 48 * MiB;
constexpr size_t WS_WABO = WS_WABI + 2 * 96 * MiB;
constexpr size_t WS_WCI  = WS_WABO + 2 * 16 * MiB;
constexpr size_t WS_WCO  = WS_WCI + 2 * 40 * MiB;
constexpr size_t WS_HB   = WS_WCO + 2 * 32 * MiB;
constexpr size_t WS_ACT  = WS_HB + 128 * MiB;
constexpr size_t WS_QKV  = WS_ACT + 192 * MiB;
constexpr size_t WS_AO   = WS_QKV + 384 * MiB;
constexpr size_t WS_PART = WS_AO + 128 * MiB;
constexpr size_t WS_END  = WS_PART + 13 * 4 * MiB;
constexpr int CW_BAR = 4096;

constexpr int RING_OFF = 0, RING_BYTES = 131072;
constexpr int RINV_OFF = RING_BYTES;
constexpr int LDSCTL_OFF = RING_BYTES + 8192, MISC_OFF = LDSCTL_OFF + 320;
constexpr int LDS_BYTES = 147456;
static_assert(MISC_OFF + 128 <= LDS_BYTES, "LDS map");

#define GAS __attribute__((address_space(1)))
#define LAS __attribute__((address_space(3)))
typedef unsigned short bf16;
typedef unsigned v4u __attribute__((ext_vector_type(4)));
typedef float f32x4 __attribute__((ext_vector_type(4)));
#define LDS_WAIT() asm volatile("s_waitcnt lgkmcnt(0)" ::: "memory")
#define VM_WAIT() asm volatile("s_waitcnt vmcnt(0)" ::: "memory")
__device__ __forceinline__ unsigned f2bf(float f) { unsigned u = __builtin_bit_cast(unsigned, f); return (u + 0x7fffu + ((u >> 16) & 1u)) >> 16; }
__device__ __forceinline__ unsigned pk2(float lo, float hi) { return f2bf(lo) | (f2bf(hi) << 16); }
__device__ __forceinline__ float bflo(unsigned p) { return __builtin_bit_cast(float, p << 16); }
__device__ __forceinline__ float bfhi(unsigned p) { return __builtin_bit_cast(float, p & 0xffff0000u); }
__device__ __forceinline__ float rdlane_f(float v, int l) { return __builtin_bit_cast(float, __builtin_amdgcn_readlane(__builtin_bit_cast(int, v), l)); }
__device__ __forceinline__ unsigned rdlane_u(unsigned v, int l) { return (unsigned)__builtin_amdgcn_readlane((int)v, l); }
__device__ __forceinline__ float wave_sum(float v) {
#pragma unroll
    for (int o = 1; o < 64; o <<= 1) v += __shfl_xor(v, o);
    return v;
}
__device__ __forceinline__ float wave_max(float v) {
#pragma unroll
    for (int o = 1; o < 64; o <<= 1) v = fmaxf(v, __shfl_xor(v, o));
    return v;
}

#define XB_TMO      128
#define XB_XCNT(j)  (256  + 64 * (j))
#define XB_XSUB(j)  (1280 + 64 * (j))
#define XB_XGEN(j)  (2304 + 64 * (j))
#define XB_TOP      3328
#define XB_TOPGEN   3392
#define XCD_BAR_WORDS 3456
#define XB_SPIN_CAP (1u << 18)

__device__ __forceinline__ unsigned xb_ld(unsigned* p)              { return __hip_atomic_load(p, __ATOMIC_RELAXED, __HIP_MEMORY_SCOPE_AGENT); }
__device__ __forceinline__ unsigned xb_add(unsigned* p, unsigned v) { return __hip_atomic_fetch_add(p, v, __ATOMIC_RELAXED, __HIP_MEMORY_SCOPE_AGENT); }
__device__ __forceinline__ unsigned xb_xcc_id() { return (unsigned)__builtin_amdgcn_s_getreg((3 << 11) | 20) & 0xFu; }
#define XB_SPIN(cond, bar) do { unsigned _sp = 0; while (cond) { __builtin_amdgcn_s_sleep(1); \
    if ((++_sp & 255u) == 0u) { if (xb_ld(&(bar)[XB_TMO])) break; if (_sp > XB_SPIN_CAP) { atomicAdd(&(bar)[XB_TMO], 1u); break; } } } } while (0)

__device__ __forceinline__ int xb_lane_id() { return (int)__builtin_amdgcn_mbcnt_hi(~0u, __builtin_amdgcn_mbcnt_lo(~0u, 0u)); }
struct XcdBarrier {
    unsigned* bar; unsigned x; int w0; unsigned total;
    volatile LAS unsigned* st;
};

__device__ __forceinline__ XcdBarrier xcd_barrier_post(unsigned* bar, volatile LAS unsigned* st, int wave, unsigned total) {
    XcdBarrier b; b.bar = bar; b.x = xb_xcc_id(); b.st = st; b.w0 = (wave == 0); b.total = total;
    if (b.w0 && xb_lane_id() == 0) (void)xb_add(&bar[XB_XCNT(b.x)], 1u);
    return b;
}
__device__ __forceinline__ void xcd_barrier_complete(unsigned* bar, unsigned x, unsigned G, unsigned& nloc, unsigned& nx) {
    unsigned sum, cnt, mine, sp = 0u;
    for (;;) {
        sum = 0u; cnt = 0u; mine = 0u;
#pragma unroll
        for (unsigned j = 0; j < 16; ++j) { const unsigned c = xb_ld(&bar[XB_XCNT(j)]); sum += c; cnt += (c > 0u) ? 1u : 0u; mine = (j == x) ? c : mine; }
        if (sum == G) break;
        __builtin_amdgcn_s_sleep(1);
        if ((++sp & 255u) == 0u) { if (xb_ld(&bar[XB_TMO])) break; if (sp > XB_SPIN_CAP) { atomicAdd(&bar[XB_TMO], 1u); break; } }
    }
    nloc = mine > 0u ? mine : 1u; nx = cnt > 0u ? cnt : 1u;
}

__device__ __forceinline__ void xcd_barrier(const XcdBarrier& b) {
    asm volatile("s_waitcnt vmcnt(0)" ::: "memory");
    __syncthreads();
    if (b.w0 && xb_lane_id() == 0) {
        unsigned* bar = b.bar;
        __builtin_amdgcn_s_waitcnt(0);
        unsigned nloc = b.st[0], nx = b.st[1];
        if (nloc == 0u) { xcd_barrier_complete(bar, b.x, b.total, nloc, nx); b.st[0] = nloc; b.st[1] = nx; }
        const unsigned old = xb_add(&bar[XB_XSUB(b.x)], 1u);
        const unsigned gen = old / nloc;
        if (old + 1u == (gen + 1u) * nloc) {
            __builtin_amdgcn_fence(__ATOMIC_RELEASE, "agent");
            asm volatile("s_waitcnt vmcnt(0)" ::: "memory");
            const unsigned og = xb_add(&bar[XB_TOP], 1u);
            const unsigned tg = og / nx;
            if (og + 1u == (tg + 1u) * nx) xb_add(&bar[XB_TOPGEN], 1u);
            else XB_SPIN(xb_ld(&bar[XB_TOPGEN]) == tg, bar);
            __builtin_amdgcn_fence(__ATOMIC_ACQUIRE, "agent");
            xb_add(&bar[XB_XGEN(b.x)], 1u);
            asm volatile("s_waitcnt vmcnt(0)" ::: "memory");
        } else {
            XB_SPIN(xb_ld(&bar[XB_XGEN(b.x)]) == gen, bar);
            __builtin_amdgcn_fence(__ATOMIC_ACQUIRE, "agent");
            asm volatile("s_waitcnt vmcnt(0)" ::: "memory");
        }
    }
    __syncthreads();
}


__device__ __forceinline__ const float* in_ptr(int k) {
    const __attribute__((address_space(4))) char* p = (const __attribute__((address_space(4))) char*)__builtin_amdgcn_kernarg_segment_ptr();
    asm volatile("" : "+s"(p));
    return *(const float* const __attribute__((address_space(4)))*)(p + 8 * k);
}
struct WDesc { const float* src; bf16* dst; const float* gain; int K, N, mode; };
__device__ __forceinline__ WDesc wdesc(int i, unsigned char* ws) {
    WDesc d;
    if (i < 8) { const int l = i >> 1, w = i & 1; d.src = (w ? in_ptr(11) : in_ptr(2)) + (size_t)l * D * (2 * DFF); d.dst = (bf16*)(ws + WS_WFFI) + (size_t)i * (2 * DFF) * D; d.K = D; d.N = 2 * DFF; d.mode = 1; d.gain = (w ? in_ptr(10) : in_ptr(1)) + (size_t)l * D; }
    else if (i < 16) { const int s = i - 8, l = s >> 1, w = s & 1; d.src = (w ? in_ptr(12) : in_ptr(3)) + (size_t)l * DFF * D; d.dst = (bf16*)(ws + WS_WFFO) + (size_t)s * D * DFF; d.K = DFF; d.N = D; d.mode = 0; d.gain = nullptr; }
    else if (i < 18) { const int e = i - 16; d.src = in_ptr(5) + (size_t)e * D * AB_IN; d.dst = (bf16*)(ws + WS_WABI) + (size_t)e * AB_IN * D; d.K = D; d.N = AB_IN; d.mode = 0; d.gain = in_ptr(4) + (size_t)(2 * e) * D; }
    else if (i < 20) { const int e = i - 18; d.src = in_ptr(6) + (size_t)e * AB_OUT * D; d.dst = (bf16*)(ws + WS_WABO) + (size_t)e * D * AB_OUT; d.K = AB_OUT; d.N = D; d.mode = 0; d.gain = nullptr; }
    else if (i < 22) { const int e = i - 20; d.src = in_ptr(7) + (size_t)e * D * C_IN; d.dst = (bf16*)(ws + WS_WCI) + (size_t)e * C_IN * D; d.K = D; d.N = C_IN; d.mode = 0; d.gain = in_ptr(4) + (size_t)(2 * e + 1) * D; }
    else { const int e = i - 22; d.src = in_ptr(8) + (size_t)e * C_OUT * D; d.dst = (bf16*)(ws + WS_WCO) + (size_t)e * D * C_OUT; d.K = C_OUT; d.N = D; d.mode = 0; d.gain = nullptr; }
    return d;
}
__device__ __forceinline__ void transpose_item(const WDesc& d, LAS float* scr, int item, int lane) {
    const int nblk = d.N / 64, kb = item / nblk, nb = item - kb * nblk, k0 = 64 * kb, n0 = 64 * nb;
    const int l16 = lane & 15, lq = lane >> 4;
#pragma unroll 4
    for (int i = 0; i < 16; ++i) { const int kk = 4 * i + lq; const f32x4 v = *(const f32x4*)(d.src + (size_t)(k0 + kk) * d.N + n0 + 4 * l16);
        LAS float* s = scr + kk * 65 + 4 * l16; s[0] = v[0]; s[1] = v[1]; s[2] = v[2]; s[3] = v[3]; }
    LDS_WAIT(); asm volatile("" ::: "memory");
    const int c = lane & 7;
    f32x4 ga = {1.f, 1.f, 1.f, 1.f}, gb = ga;
    if (d.gain) { ga = *(const f32x4*)(d.gain + k0 + 8 * c); gb = *(const f32x4*)(d.gain + k0 + 8 * c + 4); }
#pragma unroll
    for (int j = 0; j < 8; ++j) { const int n = (lane >> 3) + 8 * j; const LAS float* s = scr + (8 * c) * 65 + n;
        v4u o; o.x = pk2(s[0 * 65] * ga[0], s[1 * 65] * ga[1]); o.y = pk2(s[2 * 65] * ga[2], s[3 * 65] * ga[3]); o.z = pk2(s[4 * 65] * gb[0], s[5 * 65] * gb[1]); o.w = pk2(s[6 * 65] * gb[2], s[7 * 65] * gb[3]);
        int row = n0 + n;
        if (d.mode) { const int up = row >= DFF, jj = row - up * DFF; row = (jj >> 7) * 256 + up * 128 + (jj & 127); }
        *(v4u*)(d.dst + (size_t)row * d.K + k0 + 8 * c) = o; }
    LDS_WAIT(); asm volatile("" ::: "memory");
}
__device__ __forceinline__ void phase_prologue(unsigned char* ws, LAS unsigned char* lds, int gw, int NGW, int wave, int lane) {
    asm volatile("" : "+v"(lane));
    LAS float* scr = (LAS float*)(lds + wave * 16640);
    const int cu = gw / NWAVES, ncu = NGW / NWAVES;
    for (int i = 0; i < 24; ++i) { const WDesc d = wdesc(i, ws); const int nblk = d.N / 64, nsuper = (d.K / 512) * nblk;
        for (int sit = cu; sit < nsuper; sit += ncu) { const int kb8 = sit / nblk, nb = sit - kb8 * nblk; transpose_item(d, scr, (8 * kb8 + wave) * nblk + nb, lane); } }
    const float* x = in_ptr(0); bf16* hb = (bf16*)(ws + WS_HB); float* prt = (float*)(ws + WS_PART);
    for (int row = gw; row < M; row += NGW) {
        const f32x4* xr = (const f32x4*)(x + (size_t)row * D); float sq = 0.f;
#pragma unroll
        for (int j = 0; j < 8; ++j) { const f32x4 a = xr[(lane + 64 * j) * 2], b = xr[(lane + 64 * j) * 2 + 1];
            sq += (a[0] * a[0] + a[1] * a[1]) + (a[2] * a[2] + a[3] * a[3]) + (b[0] * b[0] + b[1] * b[1]) + (b[2] * b[2] + b[3] * b[3]);
            v4u o; o.x = pk2(a[0], a[1]); o.y = pk2(a[2], a[3]); o.z = pk2(b[0], b[1]); o.w = pk2(b[2], b[3]); *((v4u*)(hb + (size_t)row * D) + lane + 64 * j) = o; }
        prt[(size_t)row * 64 + lane] = sq;
    }
}
__device__ __forceinline__ void phase_final_norm(const bf16* xb, const float* g, float* outp, int row0, int rstep, int rend, int lane) {
    asm volatile("" : "+v"(lane));
    for (int row = row0; row < rend; row += rstep) {
        const v4u* xr = (const v4u*)(xb + (size_t)row * D);
        float v[8][8]; float s = 0.f;
#pragma unroll
        for (int j = 0; j < 8; ++j) { const v4u b = xr[lane + 64 * j];
            v[j][0] = bflo(b.x); v[j][1] = bfhi(b.x); v[j][2] = bflo(b.y); v[j][3] = bfhi(b.y); v[j][4] = bflo(b.z); v[j][5] = bfhi(b.z); v[j][6] = bflo(b.w); v[j][7] = bfhi(b.w);
#pragma unroll
            for (int e = 0; e < 8; ++e) s += v[j][e] * v[j][e]; }
        const float r = 1.0f / sqrtf(wave_sum(s) * (1.0f / D) + RMS_EPS);
        const f32x4* gr = (const f32x4*)g;
#pragma unroll
        for (int j = 0; j < 8; ++j) { const f32x4 g0 = gr[(lane + 64 * j) * 2], g1 = gr[(lane + 64 * j) * 2 + 1];
            f32x4 a = {v[j][0], v[j][1], v[j][2], v[j][3]}, b = {v[j][4], v[j][5], v[j][6], v[j][7]};
            f32x4* o = (f32x4*)(outp + (size_t)row * D) + (lane + 64 * j) * 2; o[0] = a * r * g0; o[1] = b * r * g1; }
    }
}
namespace at {
typedef short bf16x8 __attribute__((ext_vector_type(8)));
typedef float f32x16 __attribute__((ext_vector_type(16)));
typedef short s16x4 __attribute__((ext_vector_type(4)));
typedef short v4i16_t __attribute__((ext_vector_type(4)));
typedef float f32x2_t __attribute__((ext_vector_type(2))); typedef __bf16 bf16x2_t __attribute__((ext_vector_type(2)));
#define ATDI __device__ __forceinline__
#define MFMA32(a, b, c) __builtin_amdgcn_mfma_f32_32x32x16_bf16((a), (b), (c), 0, 0, 0)
constexpr float LOG2E = 1.4426950408889634f, LN2 = 0.6931471805599453f;
ATDI unsigned cvtpk(float lo, float hi) { f32x2_t v = {lo, hi}; bf16x2_t b = __builtin_convertvector(v, bf16x2_t); return __builtin_bit_cast(unsigned, b); }
ATDI s16x4 vtr(LAS const char* p) { return __builtin_bit_cast(s16x4, __builtin_amdgcn_ds_read_tr16_b64_v4i16((LAS v4i16_t*)p)); }
ATDI float xmaxh(float v) { const unsigned a = __float_as_uint(v); auto r = __builtin_amdgcn_permlane32_swap(a, a, false, false); return fmaxf(__uint_as_float(r[0]), __uint_as_float(r[1])); }
ATDI float xsumh(float v) { const unsigned a = __float_as_uint(v); auto r = __builtin_amdgcn_permlane32_swap(a, a, false, false); return __uint_as_float(r[0]) + __uint_as_float(r[1]); }
ATDI float xother(float v, int h) { const unsigned a = __float_as_uint(v); auto r = __builtin_amdgcn_permlane32_swap(a, a, false, false); return h ? __uint_as_float(r[0]) : __uint_as_float(r[1]); }
template <int HD> ATDI unsigned voff(unsigned row, unsigned ch) {
    if (HD == 128) return 256u * row + 16u * (ch ^ (((row & 3u) << 2) | ((row >> 2) & 3u)));
    else return 128u * row + 16u * (ch ^ ((((row >> 1) & 1u) << 2) | ((row >> 2) & 3u)));
}
template <int HD> struct State { bf16x8 q[HD / 16]; f32x16 o[HD / 32]; float m, l; };
ATDI unsigned q_loff(int lane, unsigned rstride_bytes) { return (unsigned)(lane & 31) * rstride_bytes + 16u * (unsigned)(lane >> 5); }
template <int HD> ATDI void load_qfrags(bf16x8 (&f)[HD / 16], const char* ubase, unsigned loff) {
#pragma unroll
    for (int s = 0; s < HD / 16; ++s) f[s] = *(const bf16x8*)(ubase + loff + 32 * s);
}
template <int HD> ATDI unsigned v_loff(int lane, unsigned rstride_bytes) { constexpr int CPR = HD / 8; return (unsigned)(lane / CPR) * rstride_bytes + 16u * (unsigned)(lane % CPR); }
template <int HD> ATDI void load_v(v4u (&vr)[HD / 16], const char* ubase, unsigned rstride_bytes, unsigned loff) {
    constexpr int CPR = HD / 8, RPI = 64 / CPR;
#pragma unroll
    for (int i = 0; i < HD / 16; ++i) vr[i] = *(const v4u*)(ubase + (size_t)i * RPI * rstride_bytes + loff);
}
typedef __amdgpu_buffer_rsrc_t rsrc_t;
ATDI rsrc_t make_rsrc(const void* base, unsigned bytes) { return __builtin_amdgcn_make_buffer_rsrc((void*)base, 0, (int)bytes, 0x00020000); }
template <int HD> ATDI void load_vb(v4u (&vr)[HD / 16], rsrc_t rs, unsigned soff, unsigned rstride_bytes, unsigned loff) {
    constexpr int CPR = HD / 8, RPI = 64 / CPR;
#pragma unroll
    for (int i = 0; i < HD / 16; ++i) vr[i] = __builtin_amdgcn_raw_buffer_load_b128(rs, (int)loff, (int)(soff + (unsigned)i * RPI * rstride_bytes), 0);
}
template <int HD> ATDI void store_v(const v4u (&vr)[HD / 16], LAS char* vl, int lane) {
    constexpr int CPR = HD / 8, RPI = 64 / CPR; const int r0 = lane / CPR, ch = lane % CPR;
#pragma unroll
    for (int i = 0; i < HD / 16; ++i) *(LAS v4u*)(vl + voff<HD>((unsigned)(r0 + RPI * i), (unsigned)ch)) = vr[i];
}
template <int HD> ATDI f32x16 qk(LAS const char* kl, const bf16x8 (&qf)[HD / 16], int lane) {
    f32x16 S;
#pragma unroll
    for (int i = 0; i < 16; ++i) S[i] = 0.f;
    const unsigned r = lane & 31, h = lane >> 5;
#pragma unroll
    for (int s = 0; s < HD / 16; ++s) { const bf16x8 kf = *(LAS const bf16x8*)(kl + voff<HD>(r, 2u * s + h)); S = MFMA32(kf, qf[s], S); }
    return S;
}
template <int HD> ATDI void stash_q(LAS char* ql, const char* ubase, unsigned loff, int lane) {
    bf16x8 f[HD / 16]; load_qfrags<HD>(f, ubase, loff);
#pragma unroll
    for (int s = 0; s < HD / 16; ++s) *(LAS bf16x8*)(ql + s * 1024 + lane * 16) = f[s];
}
template <int HD> ATDI f32x16 qk_l(LAS const char* kl, LAS const char* ql, int lane) {
    f32x16 S;
#pragma unroll
    for (int i = 0; i < 16; ++i) S[i] = 0.f;
    const unsigned r = lane & 31, h = lane >> 5;
#pragma unroll
    for (int s = 0; s < HD / 16; ++s) { const bf16x8 kf = *(LAS const bf16x8*)(kl + voff<HD>(r, 2u * s + h)); const bf16x8 qf = *(LAS const bf16x8*)(ql + s * 1024 + lane * 16); S = MFMA32(kf, qf, S); }
    return S;
}
template <int HD> ATDI void pv(f32x16 (&o)[HD / 32], const float (&p)[16], LAS const char* vl, int lane) {
    const unsigned h = lane >> 5, blk = (lane >> 4) & 1, qd = (lane & 15) >> 2, pp = lane & 3;
#pragma unroll
    for (int s = 0; s < 2; ++s) {
        bf16x8 pf; { unsigned w[4];
#pragma unroll
            for (int j = 0; j < 4; ++j) w[j] = cvtpk(p[8 * s + 2 * j], p[8 * s + 2 * j + 1]);
            typedef unsigned u4 __attribute__((ext_vector_type(4))); u4 ww = {w[0], w[1], w[2], w[3]}; pf = __builtin_bit_cast(bf16x8, ww); }
#pragma unroll
        for (int db = 0; db < HD / 32; ++db) {
            const unsigned ch = 4 * db + 2 * blk + (pp >> 1);
            const s16x4 lo = vtr(vl + voff<HD>(16 * s + 4 * h + qd, ch) + 8 * (pp & 1));
            const s16x4 hi = vtr(vl + voff<HD>(16 * s + 8 + 4 * h + qd, ch) + 8 * (pp & 1));
            const bf16x8 vf = __builtin_shufflevector(lo, hi, 0, 1, 2, 3, 4, 5, 6, 7);
            o[db] = MFMA32(vf, pf, o[db]);
        }
    }
}
template <int HD> ATDI void band_tile(State<HD>& st, const f32x16& S, LAS const char* vl, int lane, int dl, float c1, float c2, int maxd, bool need_mask) {
    const f32x16 KROV = {0.f, 1.f, 2.f, 3.f, 8.f, 9.f, 10.f, 11.f, 16.f, 17.f, 18.f, 19.f, 24.f, 25.f, 26.f, 27.f};
    const float b0 = -c2 * (float)dl;
    f32x16 sc = S * c1 + (KROV * c2 + b0);
    if (need_mask) {
#pragma unroll
        for (int v = 0; v < 16; ++v) { const int kro = (v & 3) + 8 * (v >> 2); sc[v] = ((unsigned)(dl - kro) <= (unsigned)maxd) ? sc[v] : -INFINITY; }
    }
    float tmax = fmaxf(fmaxf(sc[0], sc[1]), fmaxf(sc[2], sc[3]));
#pragma unroll
    for (int v = 4; v < 16; v += 4) tmax = fmaxf(tmax, fmaxf(fmaxf(sc[v], sc[v + 1]), fmaxf(sc[v + 2], sc[v + 3])));
    tmax = xmaxh(tmax);
    if (__any(tmax > st.m)) {
        const float mnew = fmaxf(st.m, tmax), alpha = __builtin_amdgcn_exp2f(st.m - mnew); st.m = mnew; st.l *= alpha;
#pragma unroll
        for (int db = 0; db < HD / 32; ++db) st.o[db] = st.o[db] * alpha;
    }
    sc = sc - st.m;
    float p[16]; float ps = 0.f;
#pragma unroll
    for (int v = 0; v < 16; ++v) { p[v] = __builtin_amdgcn_exp2f(sc[v]); ps += p[v]; }
    st.l += ps;
    pv<HD>(st.o, p, vl, lane);
}
template <int HD> ATDI void sb_tile(State<HD>& st, const f32x16& S, LAS const char* vl, int lane, bool diag, float scale2  , float& P) {
    const int q = lane & 31, h = lane >> 5;
    float p[16], seg[4];
#pragma unroll
    for (int a = 0; a < 4; ++a) { float run = 1.f;
#pragma unroll
        for (int j = 3; j >= 0; --j) { const int v = 4 * a + j, kro = j + 8 * a + 4 * h;
            const float z = S[v] * scale2, e = __builtin_amdgcn_exp2f(-fabsf(z)), r = __builtin_amdgcn_rcpf(1.0f + e), er = e * r;
            float sig = z >= 0.f ? r : er, keep = z >= 0.f ? er : r;
            if (diag && !(kro < q)) { sig = 0.f; keep = 1.f; }
            p[v] = sig * run; run *= keep; }
        seg[a] = run; }
    float ps[4], T[4];
#pragma unroll
    for (int a = 0; a < 4; ++a) { ps[a] = xother(seg[a], h); T[a] = seg[a] * ps[a]; }
    float aft[4]; aft[3] = 1.f; aft[2] = T[3]; aft[1] = T[3] * T[2]; aft[0] = aft[1] * T[1];
    const float total = aft[0] * T[0];
#pragma unroll
    for (int a = 0; a < 4; ++a) { const float off = aft[a] * (h == 0 ? ps[a] : 1.f) * P;
#pragma unroll
        for (int j = 0; j < 4; ++j) p[4 * a + j] *= off; }
    P *= total;
    pv<HD>(st.o, p, vl, lane);
}
template <int HD> ATDI void store_out(const State<HD>& st, float inv, bf16* orow, int h) {
#pragma unroll
    for (int db = 0; db < HD / 32; ++db)
#pragma unroll
        for (int g = 0; g < 4; ++g) { typedef unsigned u2 __attribute__((ext_vector_type(2)));
            u2 w; w.x = cvtpk(st.o[db][4 * g] * inv, st.o[db][4 * g + 1] * inv); w.y = cvtpk(st.o[db][4 * g + 2] * inv, st.o[db][4 * g + 3] * inv);
            *(u2*)(orow + 32 * db + 8 * g + 4 * h) = w; }
}
template <int HD> ATDI unsigned ost_off(unsigned row, unsigned chunk) { constexpr unsigned CPR = HD / 8; return row * (HD * 2) + 16u * (chunk ^ (row & (CPR - 1))); }
template <int HD> ATDI void stage_rows_out(LAS char* stg, rsrc_t ors, unsigned soff, unsigned rstride_bytes, int lane) {
    constexpr int CPR = HD / 8, RPI = 64 / CPR; const unsigned r0 = lane / CPR, cc = lane % CPR, voff_ = r0 * rstride_bytes + 16u * cc;
#pragma unroll
    for (int i = 0; i < HD / 16; ++i) { const v4u v = *(LAS const v4u*)(stg + ost_off<HD>(r0 + RPI * i, cc)); __builtin_amdgcn_raw_buffer_store_b128(v, ors, (int)voff_, (int)(soff + (unsigned)i * RPI * rstride_bytes), 0); }
}
template <int HD> ATDI void stage_rows_in(LAS char* stg, rsrc_t ors, unsigned soff, unsigned rstride_bytes, int lane) {
    constexpr int CPR = HD / 8, RPI = 64 / CPR; const unsigned r0 = lane / CPR, cc = lane % CPR, voff_ = r0 * rstride_bytes + 16u * cc;
#pragma unroll
    for (int ib = 0; ib < HD / 16; ib += 4) {
        v4u v[4];
#pragma unroll
        for (int i = 0; i < 4; ++i) v[i] = __builtin_amdgcn_raw_buffer_load_b128(ors, (int)voff_, (int)(soff + (unsigned)(ib + i) * RPI * rstride_bytes), 0);
#pragma unroll
        for (int i = 0; i < 4; ++i) *(LAS v4u*)(stg + ost_off<HD>(r0 + RPI * (ib + i), cc)) = v[i];
        asm volatile("" ::: "memory");
    }
}
template <int HD> ATDI void store_out_rows(const State<HD>& st, float inv, LAS char* stg, rsrc_t ors, unsigned soff, unsigned rstride_bytes, int lane) {
    const unsigned q = lane & 31, h = lane >> 5; typedef unsigned u2 __attribute__((ext_vector_type(2)));
#pragma unroll
    for (int db = 0; db < HD / 32; ++db)
#pragma unroll
        for (int g = 0; g < 4; ++g) { u2 w; w.x = cvtpk(st.o[db][4 * g] * inv, st.o[db][4 * g + 1] * inv); w.y = cvtpk(st.o[db][4 * g + 2] * inv, st.o[db][4 * g + 3] * inv);
            *(LAS u2*)(stg + ost_off<HD>(q, 4 * db + g) + 8 * h) = w; }
    stage_rows_out<HD>(stg, ors, soff, rstride_bytes, lane);
}
template <int HD> ATDI void zero_o(State<HD>& st) {
#pragma unroll
    for (int db = 0; db < HD / 32; ++db)
#pragma unroll
        for (int i = 0; i < 16; ++i) st.o[db][i] = 0.f;
}

struct CPos { int u, kt; };
ATDI int c_ktlo(int u) { const int qt = u & 127; return qt - 4 > 0 ? qt - 4 : 0; }
ATDI CPos c_next(CPos p, int G) { CPos n; if (p.kt > c_ktlo(p.u)) { n.u = p.u; n.kt = p.kt - 1; } else { n.u = p.u + G; n.kt = n.u & 127; } return n; }
ATDI const char* c_tile(const bf16* qkv, CPos p) { const int hk = (p.u >> 7) & 7, b = p.u >> 10; return (const char*)(qkv + ((size_t)(64 + hk) * M + (size_t)b * SEQ + 32 * p.kt) * 64); }
ATDI const char* c_qrow(const bf16* qkv, int u, int wave) { const int qt = u & 127, hk = (u >> 7) & 7, b = u >> 10; return (const char*)(qkv + ((size_t)(8 * hk + wave) * M + (size_t)b * SEQ + 32 * qt) * 64); }
template <int MODE = 0> ATDI void phase_attn_c(const bf16* qkv, const float* sinks, bf16* ao, LAS unsigned char* lds, int vcu  , int G  , int C_NU  , int wave, int lane) {
    asm volatile("" : "+v"(lane));
    constexpr int HD = 64;
    const int q = lane & 31, h = lane >> 5;
    const unsigned qloff = q_loff(lane, 128);
    const int isv = wave >> 2, idx = 64 * (wave & 3) + lane, prow = idx >> 3, pch = idx & 7;
    const unsigned src_off = (unsigned)prow * 128u + 16u * (unsigned)pch + (isv ? (unsigned)((size_t)8 * M * 128) : 0u);
    const unsigned dst_off = (isv ? 4096u : 0u) + voff<HD>((unsigned)prow, (unsigned)pch);
    const float c1 = 0.125f * LOG2E;
    const rsrc_t ors = make_rsrc(ao, (unsigned)((size_t)M * C_OUT * 2));
    if (vcu >= C_NU) return;
    State<HD> st; float c2 = 0.f; bf16x8 qn[4];
    CPos p0; p0.u = vcu; p0.kt = vcu & 127; CPos p1 = c_next(p0, G);
    v4u r = *(const v4u*)(c_tile(qkv, p0) + src_off);
    *(LAS v4u*)((LAS char*)lds + dst_off) = r;
    r = *(const v4u*)(c_tile(qkv, p1.u < C_NU ? p1 : p0) + src_off);
    load_qfrags<HD>(qn, c_qrow(qkv, p0.u, wave), qloff);
    asm volatile("s_waitcnt lgkmcnt(0)" ::: "memory"); __builtin_amdgcn_s_barrier(); asm volatile("" ::: "memory");
    for (int t = 0; p0.u < C_NU; ++t) {
        const int ln = lane;
        LAS char* cur = (LAS char*)lds + (t & 1) * 8192; LAS char* nxt = (LAS char*)lds + ((t + 1) & 1) * 8192;
        const CPos p2 = c_next(p1, G);
        const int qt = p0.u & 127, hq = __builtin_amdgcn_readfirstlane(8 * ((p0.u >> 7) & 7) + wave);
        *(LAS v4u*)(nxt + dst_off) = r;
        if (MODE != 2) r = *(const v4u*)(c_tile(qkv, p2.u < C_NU ? p2 : p0) + src_off);
        if (p0.kt == qt) {
#pragma unroll
            for (int s_ = 0; s_ < 4; ++s_) st.q[s_] = qn[s_];
            const float sk = sinks[hq];
            zero_o<HD>(st); st.m = sk * LOG2E; st.l = (h == 0) ? 1.0f : 0.0f; c2 = __builtin_amdgcn_exp2f(-(float)(hq + 1) * 0.125f) * LOG2E;
            const int un = p0.u + G; load_qfrags<HD>(qn, c_qrow(qkv, un < C_NU ? un : p0.u, wave), qloff);
        }
        if (MODE != 1) { const f32x16 S = qk<HD>(cur, st.q, ln);
        band_tile<HD>(st, S, cur + 4096, ln, 32 * (qt - p0.kt) + q - 4 * h, c1, c2, 127, (p0.kt == qt) || (qt - p0.kt == 4)); }
        if (MODE != 3 && p0.kt == c_ktlo(p0.u)) { const float l = xsumh(st.l); int lo_ = lane; asm volatile("" : "+v"(lo_));
            store_out_rows<HD>(st, 1.0f / l, (LAS char*)lds + 16384 + wave * 4096, ors, (unsigned)((((size_t)(p0.u >> 10) * SEQ + 32 * qt) * C_OUT + hq * 64) * 2), C_OUT * 2, lo_); }
        asm volatile("s_waitcnt lgkmcnt(0)" ::: "memory"); __builtin_amdgcn_s_barrier(); asm volatile("" ::: "memory");
        p0 = p1; p1 = p2;
    }
}
template <int HD> ATDI void a_pass(State<HD>& st, const char* qbase, unsigned qloff, rsrc_t rs, unsigned kb  , unsigned vofs  , unsigned rsb, int Q0, int qstep, float c2,
                                   LAS char* kl  , LAS char* vl  , int lane) {
    const int q = lane & 31, h = lane >> 5;
    const float c1 = 0.08838834764831845f * LOG2E;
    load_qfrags<HD>(st.q, qbase, qloff);
    int kt_lo = (Q0 - 128) >> 5; if (kt_lo < 0) kt_lo = 0; const int kt_hi = (Q0 + 31 * qstep) >> 5;
    const unsigned vloff = v_loff<HD>(lane, rsb);
    v4u kr[HD / 16], vr[HD / 16];
    load_vb<HD>(kr, rs, kb + (unsigned)(32 * kt_hi) * rsb, rsb, vloff); load_vb<HD>(vr, rs, kb + vofs + (unsigned)(32 * kt_hi) * rsb, rsb, vloff);
    for (int kt = kt_hi; kt >= kt_lo; --kt) {
        int ln = lane; asm volatile("" : "+v"(ln));
        float c2t = c2; asm volatile("" : "+v"(c2t));
        store_v<HD>(kr, kl, ln); store_v<HD>(vr, vl, ln);
        if (kt > kt_lo) { load_vb<HD>(kr, rs, kb + (unsigned)(32 * (kt - 1)) * rsb, rsb, vloff); load_vb<HD>(vr, rs, kb + vofs + (unsigned)(32 * (kt - 1)) * rsb, rsb, vloff); }
        const f32x16 S = qk<HD>(kl, st.q, ln);
        const int D0 = Q0 - 32 * kt; band_tile<HD>(st, S, vl, ln, D0 + qstep * q - 4 * h, c1, c2t, 128, (D0 < 31) || (D0 + 31 * qstep > 128));
    }
}
ATDI float a_slope2(int head, int r) { return __builtin_amdgcn_exp2f(-(float)(head + 1) * (1.0f / 3.0f)) * (float)r * LOG2E; }
ATDI void phase_attn_a(const bf16* qkv, bf16* ao, LAS unsigned char* lds, int vcu, int G, int wave, int lane) {
    asm volatile("" : "+v"(lane));
    constexpr int HD = 128; LAS char* kl = (LAS char*)lds + wave * 16384; LAS char* vl = kl + 8192;
    typedef float f32x2v __attribute__((ext_vector_type(2)));
    LAS f32x2v* ML = (LAS f32x2v*)((LAS char*)lds + 131072);
    const int q = lane & 31, h = lane >> 5;
    const rsrc_t rs = make_rsrc(qkv, (unsigned)((size_t)M * AB_IN * 2));
    constexpr unsigned AVOFS = (unsigned)((size_t)24 * M * 256);
    for (int wgu = vcu; wgu < BATCH * 8 * 8; wgu += G) {
        const int ch = wgu & 7, hs = (wgu >> 3) & 7, b = wgu >> 6;
        const size_t tokb = (size_t)b * SEQ;
#pragma unroll 1
        for (int bi = 0; bi < 2; ++bi) {
            const int blk = wave + 8 * bi, T0 = 512 * ch + 32 * blk;
            State<HD> st; zero_o<HD>(st); st.m = -1e30f; st.l = 0.f;
            a_pass<HD>(st, (const char*)(qkv + ((size_t)hs * M + tokb + T0) * 128), q_loff(lane, 256), rs, (unsigned)((((size_t)(24 + hs)) * M + tokb) * 256), AVOFS, 256u, T0, 1, a_slope2(hs, 1), kl, vl, lane);
            const float l0 = xsumh(st.l);
            store_out<HD>(st, 1.0f, ao + (tokb + T0 + q) * AB_OUT + hs * 128, h);
            if (h == 0) ML[32 * blk + q] = (f32x2v){st.m, l0};
        }
        asm volatile("s_waitcnt vmcnt(0)" ::: "memory"); __syncthreads();
#pragma unroll 1
        for (int ci = 0; ci < 2; ++ci) {
            const int c = wave + 8 * ci, tq0 = 512 * ch + c;
            State<HD> st; zero_o<HD>(st); st.m = -1e30f; st.l = 0.f;
            const unsigned qloff = q_loff(lane, 16 * 256);
#pragma unroll 1
            for (int g = 1; g < 3; ++g) { const int head = 8 * g + hs, sh = 2 * g, r = 1 << sh, cr = c & (r - 1);
                a_pass<HD>(st, (const char*)(qkv + ((size_t)head * M + tokb + tq0) * 128), qloff, rs, (unsigned)((((size_t)(24 + head)) * M + tokb + cr) * 256), AVOFS, (unsigned)r * 256u,
                           (512 >> sh) * ch + (c >> sh), 16 >> sh, a_slope2(head, r), kl, vl, lane); }
            const float l12 = xsumh(st.l);
            const f32x2v ml = ML[c + 16 * q];
            const float mt = fmaxf(st.m, ml.x), a12 = __builtin_amdgcn_exp2f(st.m - mt), a0 = __builtin_amdgcn_exp2f(ml.x - mt);
            const float inv = 1.0f / (l12 * a12 + ml.y * a0), w12 = a12 * inv, w0 = a0 * inv;
            bf16* orow = ao + (tokb + tq0 + 16 * q) * AB_OUT + hs * 128;
#pragma unroll
            for (int db = 0; db < HD / 32; ++db)
#pragma unroll
                for (int g4 = 0; g4 < 4; ++g4) { typedef unsigned u2 __attribute__((ext_vector_type(2)));
                    u2* p = (u2*)(orow + 32 * db + 8 * g4 + 4 * h); const u2 o0 = *p;
                    const float r0 = st.o[db][4 * g4] * w12 + bflo(o0.x) * w0, r1 = st.o[db][4 * g4 + 1] * w12 + bfhi(o0.x) * w0;
                    const float r2 = st.o[db][4 * g4 + 2] * w12 + bflo(o0.y) * w0, r3 = st.o[db][4 * g4 + 3] * w12 + bfhi(o0.y) * w0;
                    u2 w; w.x = cvtpk(r0, r1); w.y = cvtpk(r2, r3); *p = w; }
        }
        asm volatile("s_waitcnt vmcnt(0)" ::: "memory"); __syncthreads();
    }
}
ATDI void phase_attn_b(const bf16* qkv, bf16* ao, LAS unsigned char* lds, int wu0, int wstep, int wend, int wave, int lane) {
    asm volatile("" : "+v"(lane));
    constexpr int HD = 128; LAS char* kvl = (LAS char*)lds + wave * 16384; LAS char* ql = kvl + 8192;
    const int q = lane & 31, h = lane >> 5;
    const unsigned qloff = q_loff(lane, 256), vloff = v_loff<HD>(lane, 256);
    const rsrc_t rs = make_rsrc(qkv, (unsigned)((size_t)M * AB_IN * 2));
    const rsrc_t ors = make_rsrc(ao, (unsigned)((size_t)M * AB_OUT * 2));
    constexpr unsigned BVOFS = (unsigned)((size_t)8 * M * 256);
    for (int wu = wu0; wu < wend; wu += wstep) {
        const int qt = wu & 127, hs = (wu >> 7) & 7, b = wu >> 10;
        const size_t tokb = (size_t)b * SEQ;
        State<HD> st; zero_o<HD>(st); stash_q<HD>(ql, (const char*)(qkv + ((size_t)(72 + hs) * M + tokb + 32 * qt) * 128), qloff, lane);
        float P = 1.f;
        const unsigned kb = (unsigned)(((size_t)(80 + hs) * M + tokb) * 256);
        v4u kr[HD / 16], vr[HD / 16];
        load_vb<HD>(kr, rs, kb + (unsigned)(32 * qt) * 256u, 256u, vloff); load_vb<HD>(vr, rs, kb + BVOFS + (unsigned)(32 * qt) * 256u, 256u, vloff);
        for (int kt = qt; kt >= 0; --kt) {
            store_v<HD>(kr, kvl, lane);
            if (kt > 0) load_vb<HD>(kr, rs, kb + (unsigned)(32 * (kt - 1)) * 256u, 256u, vloff);
            const f32x16 S = qk_l<HD>(kvl, ql, lane);
            store_v<HD>(vr, kvl, lane);
            if (kt > 0) load_vb<HD>(vr, rs, kb + BVOFS + (unsigned)(32 * (kt - 1)) * 256u, 256u, vloff);
            sb_tile<HD>(st, S, kvl, lane, kt == qt, 0.08838834764831845f * LOG2E, P);
            if (__all(P < 1e-37f)) break;
        }
        store_out_rows<HD>(st, 1.0f, kvl, ors, (unsigned)(((tokb + 32 * qt) * AB_OUT + 1024 + hs * 128) * 2), AB_OUT * 2, lane);
    }
}
}


struct Args { const float* in[14]; float* out; unsigned char* ws; int ph_lo, ph_hi, li, pad; };
constexpr int GRP_WGS = 64, GRID_WGS = 4 * GRP_WGS;
__global__ void __launch_bounds__(NWAVES * 64, 2) fwd_kernel(Args args) {
    extern __shared__ __attribute__((aligned(16))) unsigned char lds_raw[];
    LAS unsigned char* lds = (LAS unsigned char*)lds_raw;
    volatile LAS unsigned* MISC = (volatile LAS unsigned*)(lds + MISC_OFF);
    const int wave = __builtin_amdgcn_readfirstlane((int)threadIdx.x >> 6);
#define LANE_ID() ((int)__builtin_amdgcn_mbcnt_hi(~0u, __builtin_amdgcn_mbcnt_lo(~0u, 0u)))
    const int G = gridDim.x, bx = blockIdx.x, vcu = (bx % 8) * (G / 8) + bx / 8;
    const int gw = vcu * NWAVES + wave, NGW = G * NWAVES;
    const int bb = (bx & 7) >> 1, xl = bx & 1, cl = bx >> 3, gci = xl * 32 + cl;
    unsigned char* ws = args.ws;
    unsigned* ctl = (unsigned*)(ws + WS_CTL);
    for (int u = wave * 64 + LANE_ID(); u < (LDS_BYTES - LDSCTL_OFF) / 4; u += NWAVES * 64) ((LAS unsigned*)(lds + LDSCTL_OFF))[u] = 0u;
    __syncthreads();
    const XcdBarrier bar0 = xcd_barrier_post(ctl + CW_BAR, MISC + 8, wave, (unsigned)G);
    const XcdBarrier bar = xcd_barrier_post(ctl + CW_BAR + (1 + bb) * XCD_BAR_WORDS, MISC + 12, wave, (unsigned)GRP_WGS);

    bf16* HB = (bf16*)(ws + WS_HB); bf16* ACT = (bf16*)(ws + WS_ACT); bf16* QKV = (bf16*)(ws + WS_QKV); bf16* AO = (bf16*)(ws + WS_AO);

    phase_prologue(ws, lds, gw, NGW, wave, LANE_ID());
    xcd_barrier(bar0);

    float* PART = (float*)(ws + WS_PART);
    LAS float* rtab = (LAS float*)(lds + RINV_OFF);
    int rs = 0;
#pragma unroll 1
    for (int s = 0; s < 8; ++s) {
        const int l = s >> 1, second = s & 1;
        { pg8::Gemm g{HB, (const bf16*)(ws + WS_WFFI) + (size_t)s * (2 * DFF) * D, M, 2 * DFF, D}; pg8::GroupOrder S; S.init(2 * DFF, 16 * bb + 8 * xl, cl, wave);
          const float* prt = PART + (size_t)rs * M * 64; pg8::rinv_panel(prt, S.pm0, rtab, wave); if (S.mode8) pg8::rinv_panel(prt, S.pm0 + 4, rtab + 256, wave);
          pg8::EpiSwiglu E{ACT, DFF, pg8::RowScale{rtab, S.pm0, prt}};
          pg8::gemm_phase<pg8::EpiSwiglu, pg8::GroupOrder, PG8_ALIGN, PG8_SP2>(lds + RING_OFF, g, S, E); }
        xcd_barrier(bar);
        { pg8::Gemm g{ACT, (const bf16*)(ws + WS_WFFO) + (size_t)s * D * DFF, M, D, DFF}; pg8::GroupOrder S; S.init(D, 16 * bb + 8 * xl, cl, wave);
          pg8::EpiResid E{HB, PART + (size_t)(rs + 1) * M * 64, D, 0.5f};
          pg8::gemm_phase<pg8::EpiResid, pg8::GroupOrder, PG8_ALIGN, PG8_SP2>(lds + RING_OFF, g, S, E); }
        if (s != 7) xcd_barrier(bar0); else xcd_barrier(bar);
        ++rs;
        if (!second) {
            const int e = l >> 1, isC = l & 1;
            { const int N = isC ? C_IN : AB_IN;
              const bf16* Wt = isC ? (const bf16*)(ws + WS_WCI) + (size_t)e * C_IN * D : (const bf16*)(ws + WS_WABI) + (size_t)e * AB_IN * D;
              pg8::Gemm g{HB, Wt, M, N, D}; pg8::GroupOrder S; S.init(N, 16 * bb + 8 * xl, cl, wave);
              const float* prt = PART + (size_t)rs * M * 64; pg8::rinv_panel(prt, S.pm0, rtab, wave); if (S.mode8) pg8::rinv_panel(prt, S.pm0 + 4, rtab + 256, wave);
              if (isC) { pg8::EpiHeads<64> E{QKV, M, pg8::RowScale{rtab, S.pm0, prt}}; pg8::gemm_phase<pg8::EpiHeads<64>, pg8::GroupOrder, PG8_ALIGN, PG8_SP2>(lds + RING_OFF, g, S, E); }
              else { pg8::EpiHeads<128> E{QKV, M, pg8::RowScale{rtab, S.pm0, prt}}; pg8::gemm_phase<pg8::EpiHeads<128>, pg8::GroupOrder, PG8_ALIGN, PG8_SP2>(lds + RING_OFF, g, S, E); } }
            xcd_barrier(bar);
            if (isC) at::phase_attn_c<0>(QKV, in_ptr(9) + e * 64, AO, lds, bb * 1024 + gci, GRP_WGS, (bb + 1) * 1024, wave, LANE_ID());
            else { at::phase_attn_a(QKV, AO, lds, bb * 64 + gci, GRID_WGS, wave, LANE_ID());
                   at::phase_attn_b(QKV, AO, lds, bb * 1024 + gci * NWAVES + wave, GRP_WGS * NWAVES, (bb + 1) * 1024, wave, LANE_ID()); }
            xcd_barrier(bar);
            { const int K = isC ? C_OUT : AB_OUT;
              const bf16* Wt = isC ? (const bf16*)(ws + WS_WCO) + (size_t)e * D * C_OUT : (const bf16*)(ws + WS_WABO) + (size_t)e * D * AB_OUT;
              pg8::Gemm g{AO, Wt, M, D, K}; pg8::GroupOrder S; S.init(D, 16 * bb + 8 * xl, cl, wave);
              pg8::EpiResid E{HB, PART + (size_t)(rs + 1) * M * 64, D, 1.0f};
              pg8::gemm_phase<pg8::EpiResid, pg8::GroupOrder, PG8_ALIGN, PG8_SP2>(lds + RING_OFF, g, S, E); }
            xcd_barrier(bar);
            ++rs;
        }
    }
    phase_final_norm(HB, in_ptr(13), (float*)in_ptr(14), bb * SEQ + gci * NWAVES + wave, GRP_WGS * NWAVES, (bb + 1) * SEQ, LANE_ID());
#undef LANE_ID
}

extern "C" void kernel_launch(void* const* d_in, const int* in_sizes, int n_in, void* d_out, int out_size, void* d_ws, size_t ws_size, hipStream_t stream) {
    static int grid = 0;
    if (grid == 0) {
        if (n_in != 14 || in_sizes[0] != M * D || out_size != M * D || ws_size < WS_END) { fprintf(stderr, "kernel_launch: unexpected shapes (n_in %d, in0 %d, out %d, ws %zu < %zu); nothing launched\n", n_in, n_in > 0 ? in_sizes[0] : -1, out_size, ws_size, (size_t)WS_END); grid = -1; return; }
        int dev = 0, cus = 0, per_cu = 0;
        if (hipGetDevice(&dev) != hipSuccess || hipDeviceGetAttribute(&cus, hipDeviceAttributeMultiprocessorCount, dev) != hipSuccess) { fprintf(stderr, "kernel_launch: device query failed\n"); grid = -1; return; }
        if (hipFuncSetAttribute((const void*)fwd_kernel, hipFuncAttributeMaxDynamicSharedMemorySize, LDS_BYTES) != hipSuccess) { fprintf(stderr, "kernel_launch: hipFuncSetAttribute failed\n"); grid = -1; return; }
        if (hipOccupancyMaxActiveBlocksPerMultiprocessor(&per_cu, (const void*)fwd_kernel, NWAVES * 64, LDS_BYTES) != hipSuccess || per_cu < 1) fprintf(stderr, "kernel_launch: note: occupancy query reports %d workgroups per CU\n", per_cu);
        (void)hipGetLastError();
        if (cus != GRID_WGS) { fprintf(stderr, "kernel_launch: this kernel is laid out for %d CUs with one resident workgroup each (found %d CUs, %d workgroups per CU); nothing launched\n", GRID_WGS, cus, per_cu); grid = -1; return; }
        grid = GRID_WGS;
    }
    if (grid < 0) return;
    if (hipMemsetAsync((char*)d_ws + WS_CTL, 0, CTL_ZERO_BYTES, stream) != hipSuccess) { fprintf(stderr, "kernel_launch: memset failed\n"); return; }
    Args a{};
    for (int i = 0; i < 14; ++i) a.in[i] = (const float*)d_in[i];
    a.out = (float*)d_out; a.ws = (unsigned char*)d_ws;
    a.ph_lo = 0; a.ph_hi = N_PHASES; a.li = 0;
    hipLaunchKernelGGL(fwd_kernel, dim3(grid), dim3(NWAVES * 64), LDS_BYTES, stream, a);
    const hipError_t le = hipPeekAtLastError();
    if (le != hipSuccess) fprintf(stderr, "kernel_launch: launch failed: %s\n", hipGetErrorName(le));
}
```

```cpp
#include <hip/hip_runtime.h>
#include <cstdio>
#include <cstdint>

namespace pg8 {
#define PG8_LAS __attribute__((address_space(3)))
typedef unsigned short bf16_t;
typedef short bf16x8 __attribute__((ext_vector_type(8)));
typedef float f32x4 __attribute__((ext_vector_type(4)));
typedef unsigned u32x4 __attribute__((ext_vector_type(4)));
constexpr int BM = 256, BK = 64, HALF = 128, HTB = HALF * BK * 2  , STAGE_BYTES = 8 * HTB, NXCD = 8, WGM = 8;

__host__ __device__ __forceinline__ int lds_byte(int r, int c) { const int st = (r >> 4) * 2 + (c >> 5), rr = r & 15, cc = c & 31, ob = rr * 64 + cc * 2; return st * 1024 + (ob ^ (((ob >> 9) & 1) << 5)); }
__host__ __device__ __forceinline__ void stage_rc(int b, int& R, int& C) { const int st = b / 1024, sb = b % 1024, swz = sb ^ (((sb >> 9) & 1) << 5); R = (st >> 1) * 16 + swz / 64; C = (st & 1) * 32 + (swz % 64) / 2; }
__host__ __device__ __forceinline__ int perm32(int rho) { const int n = rho >> 4, i = rho & 15; return 8 * (i >> 2) + 4 * n + (i & 3); }

struct Unit { int pm, pn; };
struct Gemm { const bf16_t* A; const bf16_t* Bt; int M, N, K; };

struct StaticOrder {
    int nM, nN, nwg, G, c, wave;
    __host__ __device__ void init(int M, int N, int G_, int c_, int wave_ = 0) { nM = M / BM; nN = N / BM; nwg = nM * nN; G = G_; c = c_; wave = wave_; }
    __host__ __device__ bool next(int i, Unit& u) const {
        const long L = (long)i * G + c; if (L >= nwg) return false;
        int wgid = (int)L; { const int q = nwg / NXCD, r = nwg % NXCD, xcd = wgid % NXCD, off = wgid / NXCD; wgid = (xcd < r ? xcd * (q + 1) : r * (q + 1) + (xcd - r) * q) + off; }
        const int nig = WGM * nN, gid = wgid / nig, fm = gid * WGM, gsz = (nM - fm) < WGM ? (nM - fm) : WGM;
        u.pm = fm + ((wgid % nig) % gsz); u.pn = (wgid % nig) / gsz; return true;
    }
    __device__ __forceinline__ void a_ready(const Unit&) const {}
    __device__ __forceinline__ void done(const Unit&) const {}
};

struct GroupOrder {
    int nU, mode8, pm0, pnb, wave;
    __host__ __device__ void init(int N, int base, int cl, int wave_) { const int nN = N / BM; nU = nN / 4; mode8 = (nN % 8 == 0); pm0 = base + (mode8 ? (cl & 3) : (cl & 7)); pnb = mode8 ? (cl >> 2) : (cl >> 3); wave = wave_; }
    __device__ __forceinline__ bool next(int i, Unit& u) const { if (i >= nU) return false; int p = mode8 ? pm0 + 4 * (i & 1) : pm0; asm volatile("" : "+s"(p)); u.pm = p; u.pn = mode8 ? 8 * (i >> 1) + pnb : 4 * i + pnb; return true; }
    __device__ __forceinline__ void a_ready(const Unit&) const {}
    __device__ __forceinline__ void done(const Unit&) const {}
};

__device__ __forceinline__ unsigned cvt_pk_bf16(float lo, float hi) { unsigned r; asm volatile("v_cvt_pk_bf16_f32 %0, %1, %2" : "=v"(r) : "v"(lo), "v"(hi)); return r; }

typedef float f32x2 __attribute__((ext_vector_type(2)));
__device__ __forceinline__ float silu_f(float g) { return g * __builtin_amdgcn_rcpf(1.0f + __builtin_amdgcn_exp2f(-1.44269504089f * g)); }
constexpr float K_NORM_INV = 1.0f / 4096.0f, K_NORM_EPS = 1e-6f;
constexpr int NPART = 64;
struct RowScale {
    PG8_LAS const float* tab; int pm0; const float* part;
    __device__ __forceinline__ float get(int pm, int r  ) const { return tab[(pm != pm0 ? 256 : 0) + r]; }
};
__device__ __forceinline__ void rinv_panel(const float* part, int pm, PG8_LAS float* tab, int wave) {
    const int tid = wave * 64 + (int)__builtin_amdgcn_mbcnt_hi(~0u, __builtin_amdgcn_mbcnt_lo(~0u, 0u));
    const int r = tid >> 1, hf = tid & 1; const f32x4* p = (const f32x4*)(part + (size_t)(pm * BM + r) * NPART + hf * 32);
    f32x4 a = p[0];
#pragma unroll
    for (int i = 1; i < 8; ++i) a += p[i];
    float sm = (a[0] + a[1]) + (a[2] + a[3]); sm += __shfl_xor(sm, 1);
    if (hf == 0) tab[r] = __builtin_amdgcn_rsqf(sm * K_NORM_INV + K_NORM_EPS);
    __syncthreads();
}
template <int HD> struct EpiHeads {
    static constexpr bool PERM = true, AFTER_DRAIN = false;
    bf16_t* O; int mtot; RowScale rsc;
    __device__ __forceinline__ void operator()(const f32x4 (&acc)[2][2][4][2], const Unit& u, int wr, int wc, int fr, int fq) const {
        const int row0 = u.pm * BM + wr * 64 + fr;
#pragma unroll
        for (int ai = 0; ai < 2; ++ai)
#pragma unroll
            for (int m = 0; m < 4; ++m) { const int row = row0 + ai * HALF + m * 16; const float ri = rsc.get(u.pm, row - u.pm * BM);
#pragma unroll
                for (int bj = 0; bj < 2; ++bj) { const f32x4 v0 = acc[ai][bj][m][0] * ri, v1 = acc[ai][bj][m][1] * ri;
                    const int tcol = bj * HALF + wc * 32 + 8 * fq;
                    const int head = u.pn * (BM / HD) + tcol / HD, hcol = tcol % HD;
                    u32x4 w; w.x = cvt_pk_bf16(v0[0], v0[1]); w.y = cvt_pk_bf16(v0[2], v0[3]); w.z = cvt_pk_bf16(v1[0], v1[1]); w.w = cvt_pk_bf16(v1[2], v1[3]);
                    *(u32x4*)(O + ((size_t)head * mtot + row) * HD + hcol) = w; } }
    }
};
struct EpiSwiglu {
    static constexpr bool PERM = true, AFTER_DRAIN = false;
    bf16_t* O; int ldc; RowScale rsc;
    __device__ __forceinline__ void operator()(const f32x4 (&acc)[2][2][4][2], const Unit& u, int wr, int wc, int fr, int fq) const {
        const int row0 = u.pm * BM + wr * 64 + fr, col0 = u.pn * HALF + wc * 32 + 8 * fq;
#pragma unroll
        for (int ai = 0; ai < 2; ++ai)
#pragma unroll
            for (int m = 0; m < 4; ++m) { const int row = row0 + ai * HALF + m * 16; bf16_t* rowp = O + (size_t)row * ldc + col0; const float ri = rsc.get(u.pm, row - u.pm * BM);
                const float na = ri * -1.44269504089f, ri2 = ri * ri;
                const f32x4 g0 = acc[ai][0][m][0], g1 = acc[ai][0][m][1], u0 = acc[ai][1][m][0], u1 = acc[ai][1][m][1];
                f32x4 t0 = g0 * na, t1 = g1 * na;
#pragma unroll
                for (int j = 0; j < 4; ++j) { t0[j] = __builtin_amdgcn_exp2f(t0[j]); t1[j] = __builtin_amdgcn_exp2f(t1[j]); }
                t0 = t0 + 1.0f; t1 = t1 + 1.0f;
#pragma unroll
                for (int j = 0; j < 4; ++j) { t0[j] = __builtin_amdgcn_rcpf(t0[j]); t1[j] = __builtin_amdgcn_rcpf(t1[j]); }
                const f32x4 h0 = (g0 * u0) * ri2 * t0, h1 = (g1 * u1) * ri2 * t1;
                u32x4 w; w.x = cvt_pk_bf16(h0[0], h0[1]); w.y = cvt_pk_bf16(h0[2], h0[3]); w.z = cvt_pk_bf16(h1[0], h1[1]); w.w = cvt_pk_bf16(h1[2], h1[3]);
                *(u32x4*)rowp = w; }
    }
};
struct EpiResid {
    static constexpr bool PERM = true, AFTER_DRAIN = false;
    bf16_t* xb; float* part; int ldc; float scale;
    __device__ __forceinline__ void operator()(const f32x4 (&acc)[2][2][4][2], const Unit& u, int wr, int wc, int fr, int fq) const {
        const int row0 = u.pm * BM + wr * 64 + fr, col0 = u.pn * BM + wc * 32 + 8 * fq;
#pragma unroll
        for (int ai = 0; ai < 2; ++ai) {
        u32x4 bs[4][2];
#pragma unroll
            for (int m = 0; m < 4; ++m) { const size_t off = (size_t)(row0 + ai * HALF + m * 16) * ldc + col0;
#pragma unroll
                for (int bj = 0; bj < 2; ++bj) bs[m][bj] = *(const u32x4*)(xb + off + bj * HALF); }
#pragma unroll
            for (int m = 0; m < 4; ++m) { const int row = row0 + ai * HALF + m * 16; const size_t off = (size_t)row * ldc + col0; float ss = 0.f;
#pragma unroll
                for (int bj = 0; bj < 2; ++bj) { const u32x4 b = bs[m][bj]; f32x4 v0, v1;
                    v0[0] = __builtin_bit_cast(float, b.x << 16); v0[1] = __builtin_bit_cast(float, b.x & 0xffff0000u); v0[2] = __builtin_bit_cast(float, b.y << 16); v0[3] = __builtin_bit_cast(float, b.y & 0xffff0000u);
                    v1[0] = __builtin_bit_cast(float, b.z << 16); v1[1] = __builtin_bit_cast(float, b.z & 0xffff0000u); v1[2] = __builtin_bit_cast(float, b.w << 16); v1[3] = __builtin_bit_cast(float, b.w & 0xffff0000u);
                    v0 = v0 + acc[ai][bj][m][0] * scale; v1 = v1 + acc[ai][bj][m][1] * scale;
                    u32x4 w; w.x = cvt_pk_bf16(v0[0], v0[1]); w.y = cvt_pk_bf16(v0[2], v0[3]); w.z = cvt_pk_bf16(v1[0], v1[1]); w.w = cvt_pk_bf16(v1[2], v1[3]);
                    *(u32x4*)(xb + off + bj * HALF) = w;
                    ss += (v0[0] * v0[0] + v0[1] * v0[1]) + (v0[2] * v0[2] + v0[3] * v0[3]) + (v1[0] * v1[0] + v1[1] * v1[1]) + (v1[2] * v1[2] + v1[3] * v1[3]); }
                ss += __shfl_xor(ss, 16); ss += __shfl_xor(ss, 32);
                if (fq == 0) part[(size_t)row * NPART + u.pn * 4 + wc] = ss; }
            asm volatile("" ::: "memory"); }
    }
};


template <class Epi, class Sched, bool ALIGN_EPI = false, bool SP2 = false>
__device__ __forceinline__ void gemm_phase(PG8_LAS unsigned char* lds, const Gemm g, const Sched& S, const Epi& E) {
    int lane_l = (int)__builtin_amdgcn_mbcnt_hi(~0u, __builtin_amdgcn_mbcnt_lo(~0u, 0u)); asm volatile("" : "+v"(lane_l));
    const int wid = __builtin_amdgcn_readfirstlane(S.wave), lane = lane_l, tid = wid * 64 + lane, wr = wid >> 2, wc = wid & 3, fr = lane & 15, fq = lane >> 4;
    const int K = g.K, nt = K / BK;
    unsigned voffA[2], voffB[2];
#pragma unroll
    for (int i = 0; i < 2; ++i) { int R, C; stage_rc(tid * 16 + i * 8192, R, C); const int Rb = Epi::PERM ? ((R & ~31) + perm32(R & 31)) : R;
        voffA[i] = (unsigned)(R * K + C) * 2u; voffB[i] = (unsigned)(Rb * K + C) * 2u; }
    const size_t kstep = (size_t)(BK * 2);
    const size_t hstep = (size_t)HALF * K * 2;
    const size_t tstep = 2 * hstep;
    const unsigned ldsw = (unsigned)wid * 1024u;
    const int aoff = lds_byte(wr * 64 + fr, fq * 8), boff = lds_byte(wc * 32 + fr, fq * 8);
#define PG8_SA(b, h) (((b) * 2 + (h)) * HTB)
#define PG8_SB(b, h) ((4 + (b) * 2 + (h)) * HTB)
#define PG8_STAGE(bufoff, gbase, voff) do { _Pragma("unroll") for (int _i = 0; _i < 2; ++_i) \
        __builtin_amdgcn_global_load_lds((const unsigned*)((const char*)(gbase) + (voff)[_i]), (PG8_LAS unsigned*)(lds + (bufoff) + ldsw + _i * 8192), 16, 0, 0); } while (0)
#define PG8_LDA(dst, b, h) do { _Pragma("unroll") for (int m = 0; m < 4; ++m) _Pragma("unroll") for (int k = 0; k < 2; ++k) dst[m][k] = *(const PG8_LAS bf16x8*)(lds + PG8_SA(b, h) + aoff + m * 2048 + k * 1024); } while (0)
#define PG8_LDB(dst, b, h) do { _Pragma("unroll") for (int n = 0; n < 2; ++n) _Pragma("unroll") for (int k = 0; k < 2; ++k) dst[n][k] = *(const PG8_LAS bf16x8*)(lds + PG8_SB(b, h) + boff + n * 2048 + k * 1024); } while (0)
#define PG8_MMA(ai, bj, At, Bt) do { __builtin_amdgcn_s_setprio(1); _Pragma("unroll") for (int m = 0; m < 4; ++m) _Pragma("unroll") for (int n = 0; n < 2; ++n) _Pragma("unroll") for (int k = 0; k < 2; ++k) \
        acc[ai][bj][m][n] = __builtin_amdgcn_mfma_f32_16x16x32_bf16(Bt[n][k], At[m][k], acc[ai][bj][m][n], 0, 0, 0); __builtin_amdgcn_s_setprio(0); } while (0)
#define PG8_WAIT_V(n) asm volatile("s_waitcnt vmcnt(" #n ")" ::: "memory")
#define PG8_WAIT_L(n) asm volatile("s_waitcnt lgkmcnt(" #n ")" ::: "memory")
#define PG8_BAR __builtin_amdgcn_s_barrier()
#define PG8_SCHED __builtin_amdgcn_sched_barrier(0)
    Unit cur, nxt; int ui = 0;
    if (!S.next(0, cur)) return;
    f32x4 acc[2][2][4][2];
#pragma unroll
    for (int a = 0; a < 2; ++a)
#pragma unroll
        for (int b = 0; b < 2; ++b)
#pragma unroll
            for (int m = 0; m < 4; ++m)
#pragma unroll
                for (int n = 0; n < 2; ++n) acc[a][b][m][n] = (f32x4){0.f, 0.f, 0.f, 0.f};
    bf16x8 At[4][2], B0[2][2], B1[2][2];
    const char* cA = (const char*)g.A + (size_t)cur.pm * tstep; const char* cB = (const char*)g.Bt + (size_t)cur.pn * tstep;
    S.a_ready(cur);
    if constexpr (SP2) {
        PG8_STAGE(PG8_SB(0, 0), cB, voffB); PG8_STAGE(PG8_SB(0, 1), cB + hstep, voffB); PG8_STAGE(PG8_SA(0, 0), cA, voffA); PG8_STAGE(PG8_SA(0, 1), cA + hstep, voffA);
        if (wr == 1) PG8_BAR;
        PG8_WAIT_V(2); PG8_BAR;
        PG8_STAGE(PG8_SB(1, 0), cB + kstep, voffB); PG8_STAGE(PG8_SA(1, 0), cA + kstep, voffA); PG8_STAGE(PG8_SB(1, 1), cB + hstep + kstep, voffB);
        PG8_WAIT_V(6); PG8_BAR;
    } else {
        PG8_STAGE(PG8_SB(0, 0), cB, voffB); PG8_STAGE(PG8_SA(0, 0), cA, voffA); PG8_STAGE(PG8_SB(0, 1), cB + hstep, voffB); PG8_STAGE(PG8_SA(0, 1), cA + hstep, voffA);
        if (wr == 1) PG8_BAR;
        PG8_WAIT_V(4); PG8_BAR;
        PG8_STAGE(PG8_SB(1, 0), cB + kstep, voffB); PG8_STAGE(PG8_SA(1, 0), cA + kstep, voffA); PG8_STAGE(PG8_SB(1, 1), cB + hstep + kstep, voffB);
        PG8_WAIT_V(6); PG8_BAR;
    }
    for (;;) {
        const bool has_next = S.next(ui + 1, nxt);
        const char* nA = has_next ? (const char*)g.A + (size_t)nxt.pm * tstep : cA; const char* nB = has_next ? (const char*)g.Bt + (size_t)nxt.pn * tstep : cB;
        for (int t = 0; t < nt; t += 2) {
            const bool last = (t == nt - 2);
            const char* a1 = cA + (size_t)(t + 1) * kstep;
            const char* a2 = last ? nA : cA + (size_t)(t + 2) * kstep; const char* b2 = last ? nB : cB + (size_t)(t + 2) * kstep;
            const char* a3 = a2 + kstep; const char* b3 = b2 + kstep;
            if (last && has_next) S.a_ready(nxt);
            if constexpr (SP2) {
            PG8_LDB(B0, 0, 0); PG8_LDB(B1, 0, 1); PG8_SCHED; PG8_LDA(At, 0, 0); PG8_STAGE(PG8_SA(1, 1), a1 + hstep, voffA);
            PG8_WAIT_V(8); PG8_WAIT_L(0); PG8_BAR; PG8_MMA(0, 0, At, B0); PG8_MMA(0, 1, At, B1); PG8_BAR; PG8_SCHED;
            PG8_LDA(At, 0, 1); PG8_STAGE(PG8_SB(0, 0), b2, voffB); PG8_STAGE(PG8_SB(0, 1), b2 + hstep, voffB); PG8_STAGE(PG8_SA(0, 0), a2, voffA);
            PG8_WAIT_V(8); PG8_WAIT_L(0); PG8_BAR; PG8_MMA(1, 0, At, B0); PG8_MMA(1, 1, At, B1); PG8_BAR; PG8_SCHED;
            PG8_LDB(B0, 1, 0); PG8_LDB(B1, 1, 1); PG8_SCHED; PG8_LDA(At, 1, 0); PG8_STAGE(PG8_SA(0, 1), a2 + hstep, voffA);
            PG8_WAIT_V(8); PG8_WAIT_L(0); PG8_BAR; PG8_MMA(0, 0, At, B0); PG8_MMA(0, 1, At, B1); PG8_BAR; PG8_SCHED;
            PG8_LDA(At, 1, 1); PG8_STAGE(PG8_SB(1, 0), b3, voffB); PG8_STAGE(PG8_SB(1, 1), b3 + hstep, voffB); PG8_STAGE(PG8_SA(1, 0), a3, voffA);
            PG8_WAIT_V(8); PG8_WAIT_L(0); PG8_BAR; PG8_MMA(1, 0, At, B0); PG8_MMA(1, 1, At, B1); PG8_BAR; PG8_SCHED;
            } else {
            PG8_LDB(B0, 0, 0); PG8_SCHED; PG8_LDA(At, 0, 0); PG8_STAGE(PG8_SA(1, 1), a1 + hstep, voffA);
            PG8_WAIT_L(8); PG8_BAR; PG8_WAIT_L(0); PG8_MMA(0, 0, At, B0); PG8_BAR; PG8_SCHED;
            PG8_LDB(B1, 0, 1); PG8_STAGE(PG8_SB(0, 0), b2, voffB);
            PG8_BAR; PG8_WAIT_L(0); PG8_MMA(0, 1, At, B1); PG8_BAR;
            PG8_LDA(At, 0, 1); PG8_STAGE(PG8_SA(0, 0), a2, voffA);
            PG8_BAR; PG8_WAIT_L(0); PG8_MMA(1, 0, At, B0); PG8_BAR; PG8_SCHED;
            PG8_STAGE(PG8_SB(0, 1), b2 + hstep, voffB);
            PG8_WAIT_V(6); PG8_BAR; PG8_MMA(1, 1, At, B1); PG8_BAR;
            PG8_LDB(B0, 1, 0); PG8_SCHED; PG8_LDA(At, 1, 0); PG8_STAGE(PG8_SA(0, 1), a2 + hstep, voffA);
            PG8_WAIT_L(8); PG8_BAR; PG8_WAIT_L(0); PG8_MMA(0, 0, At, B0); PG8_BAR; PG8_SCHED;
            PG8_LDB(B1, 1, 1); PG8_STAGE(PG8_SB(1, 0), b3, voffB);
            PG8_BAR; PG8_WAIT_L(0); PG8_MMA(0, 1, At, B1); PG8_BAR;
            PG8_LDA(At, 1, 1); PG8_STAGE(PG8_SA(1, 0), a3, voffA);
            PG8_BAR; PG8_WAIT_L(0); PG8_MMA(1, 0, At, B0); PG8_BAR; PG8_SCHED;
            PG8_STAGE(PG8_SB(1, 1), b3 + hstep, voffB);
            PG8_WAIT_V(6); PG8_BAR; PG8_MMA(1, 1, At, B1); PG8_BAR;
            }
        }
        if constexpr (ALIGN_EPI) { if (wr == 0) PG8_BAR; }
        if constexpr (!Epi::AFTER_DRAIN) { E(acc, cur, wr, wc, fr, fq); S.done(cur); }
        if (!has_next) break;
#pragma unroll
        for (int a = 0; a < 2; ++a)
#pragma unroll
            for (int b = 0; b < 2; ++b)
#pragma unroll
                for (int m = 0; m < 4; ++m)
#pragma unroll
                    for (int n = 0; n < 2; ++n) acc[a][b][m][n] = (f32x4){0.f, 0.f, 0.f, 0.f};
        cur = nxt; cA = nA; cB = nB; ++ui;
        if constexpr (ALIGN_EPI) { if (wr == 1) PG8_BAR; }
    }
    PG8_WAIT_V(0);
    if constexpr (!ALIGN_EPI) { if (wr == 0) PG8_BAR; }
    PG8_BAR;
    if constexpr (Epi::AFTER_DRAIN) { E.fused(acc, cur, wr, wc, fr, fq, lds, wid, lane); S.done(cur); }
#undef PG8_SA
#undef PG8_SB
#undef PG8_STAGE
#undef PG8_LDA
#undef PG8_LDB
#undef PG8_MMA
#undef PG8_WAIT_V
#undef PG8_WAIT_L
#undef PG8_BAR
#undef PG8_SCHED
}
}

#ifndef PG8_SP2
#define PG8_SP2 true
#endif
#ifndef PG8_ALIGN
#define PG8_ALIGN true
#endif
#ifndef PROBE_DUP
#define PROBE_DUP 0
#endif
#ifndef MK_PER_PHASE
#define MK_PER_PHASE 0
#endif

constexpr int NWAVES = 8;
constexpr int BATCH = 4, SEQ = 4096, D = 4096, DEPTH = 4, M = BATCH * SEQ;
constexpr int DFF = 6144, AB_IN = 12288, AB_OUT = 2048, C_IN = 5120, C_OUT = 4096;
constexpr float RMS_EPS = 1e-6f;
constexpr int N_PHASES = 1 + 8 * 3 + 4 * 3 + 1;

constexpr size_t MiB = 1u << 20;
constexpr size_t WS_CTL = 0, CTL_ZERO_BYTES = 1 * MiB;
constexpr size_t WS_WFFI = 1 * MiB;
constexpr size_t WS_WFFO = WS_WFFI + 8 * 96 * MiB;
constexpr size_t WS_WABI = WS_WFFO + 8 * 48 * MiB;
constexpr size_t WS_WABO = WS_WABI + 2 * 96 * MiB;
constexpr size_t WS_WCI  = WS_WABO + 2 * 16 * MiB;
constexpr size_t WS_WCO  = WS_WCI + 2 * 40 * MiB;
constexpr size_t WS_HB   = WS_WCO + 2 * 32 * MiB;
constexpr size_t WS_ACT  = WS_HB + 128 * MiB;
constexpr size_t WS_QKV  = WS_ACT + 192 * MiB;
constexpr size_t WS_AO   = WS_QKV + 384 * MiB;
constexpr size_t WS_PART = WS_AO + 128 * MiB;
constexpr size_t WS_END  = WS_PART + 13 * 4 * MiB;
constexpr int CW_BAR = 4096;

constexpr int RING_OFF = 0, RING_BYTES = 131072;
constexpr int RINV_OFF = RING_BYTES;
constexpr int LDSCTL_OFF = RING_BYTES + 8192, MISC_OFF = LDSCTL_OFF + 320;
constexpr int LDS_BYTES = 147456;
static_assert(MISC_OFF + 128 <= LDS_BYTES, "LDS map");

#define GAS __attribute__((address_space(1)))
#define LAS __attribute__((address_space(3)))
typedef unsigned short bf16;
typedef unsigned v4u __attribute__((ext_vector_type(4)));
typedef float f32x4 __attribute__((ext_vector_type(4)));
#define LDS_WAIT() asm volatile("s_waitcnt lgkmcnt(0)" ::: "memory")
#define VM_WAIT() asm volatile("s_waitcnt vmcnt(0)" ::: "memory")
__device__ __forceinline__ unsigned f2bf(float f) { unsigned u = __builtin_bit_cast(unsigned, f); return (u + 0x7fffu + ((u >> 16) & 1u)) >> 16; }
__device__ __forceinline__ unsigned pk2(float lo, float hi) { unsigned r; asm volatile("v_cvt_pk_bf16_f32 %0, %1, %2" : "=v"(r) : "v"(lo), "v"(hi)); return r; }
__device__ __forceinline__ float bflo(unsigned p) { return __builtin_bit_cast(float, p << 16); }
__device__ __forceinline__ float bfhi(unsigned p) { return __builtin_bit_cast(float, p & 0xffff0000u); }
__device__ __forceinline__ float rdlane_f(float v, int l) { return __builtin_bit_cast(float, __builtin_amdgcn_readlane(__builtin_bit_cast(int, v), l)); }
__device__ __forceinline__ unsigned rdlane_u(unsigned v, int l) { return (unsigned)__builtin_amdgcn_readlane((int)v, l); }
__device__ __forceinline__ float wave_sum(float v) {
#pragma unroll
    for (int o = 1; o < 64; o <<= 1) v += __shfl_xor(v, o);
    return v;
}
__device__ __forceinline__ float wave_max(float v) {
#pragma unroll
    for (int o = 1; o < 64; o <<= 1) v = fmaxf(v, __shfl_xor(v, o));
    return v;
}

#define XB_TMO      128
#define XB_XCNT(j)  (256  + 64 * (j))
#define XB_XSUB(j)  (1280 + 64 * (j))
#define XB_XGEN(j)  (2304 + 64 * (j))
#define XB_TOP      3328
#define XB_TOPGEN   3392
#define XCD_BAR_WORDS 3456
#define XB_SPIN_CAP (1u << 18)

__device__ __forceinline__ unsigned xb_ld(unsigned* p)              { return __hip_atomic_load(p, __ATOMIC_RELAXED, __HIP_MEMORY_SCOPE_AGENT); }
__device__ __forceinline__ unsigned xb_add(unsigned* p, unsigned v) { return __hip_atomic_fetch_add(p, v, __ATOMIC_RELAXED, __HIP_MEMORY_SCOPE_AGENT); }
__device__ __forceinline__ unsigned xb_xcc_id() { return (unsigned)__builtin_amdgcn_s_getreg((3 << 11) | 20) & 0xFu; }
#define XB_SPIN(cond, bar) do { unsigned _sp = 0; while (cond) { __builtin_amdgcn_s_sleep(1); \
    if ((++_sp & 255u) == 0u) { if (xb_ld(&(bar)[XB_TMO])) break; if (_sp > XB_SPIN_CAP) { atomicAdd(&(bar)[XB_TMO], 1u); break; } } } } while (0)

__device__ __forceinline__ int xb_lane_id() { return (int)__builtin_amdgcn_mbcnt_hi(~0u, __builtin_amdgcn_mbcnt_lo(~0u, 0u)); }
struct XcdBarrier {
    unsigned* bar; unsigned x; int w0; unsigned total;
    volatile LAS unsigned* st;
};

__device__ __forceinline__ XcdBarrier xcd_barrier_post(unsigned* bar, volatile LAS unsigned* st, int wave, unsigned total) {
    XcdBarrier b; b.bar = bar; b.x = xb_xcc_id(); b.st = st; b.w0 = (wave == 0); b.total = total;
    if (b.w0 && xb_lane_id() == 0) (void)xb_add(&bar[XB_XCNT(b.x)], 1u);
    return b;
}
__device__ __forceinline__ void xcd_barrier_complete(unsigned* bar, unsigned x, unsigned G, unsigned& nloc, unsigned& nx) {
    unsigned sum, cnt, mine, sp = 0u;
    for (;;) {
        sum = 0u; cnt = 0u; mine = 0u;
#pragma unroll
        for (unsigned j = 0; j < 16; ++j) { const unsigned c = xb_ld(&bar[XB_XCNT(j)]); sum += c; cnt += (c > 0u) ? 1u : 0u; mine = (j == x) ? c : mine; }
        if (sum == G) break;
        __builtin_amdgcn_s_sleep(1);
        if ((++sp & 255u) == 0u) { if (xb_ld(&bar[XB_TMO])) break; if (sp > XB_SPIN_CAP) { atomicAdd(&bar[XB_TMO], 1u); break; } }
    }
    nloc = mine > 0u ? mine : 1u; nx = cnt > 0u ? cnt : 1u;
}

__device__ __forceinline__ void xcd_barrier(const XcdBarrier& b) {
    asm volatile("s_waitcnt vmcnt(0)" ::: "memory");
    __syncthreads();
    if (b.w0 && xb_lane_id() == 0) {
        unsigned* bar = b.bar;
        __builtin_amdgcn_s_waitcnt(0);
        unsigned nloc = b.st[0], nx = b.st[1];
        if (nloc == 0u) { xcd_barrier_complete(bar, b.x, b.total, nloc, nx); b.st[0] = nloc; b.st[1] = nx; }
        const unsigned old = xb_add(&bar[XB_XSUB(b.x)], 1u);
        const unsigned gen = old / nloc;
        if (old + 1u == (gen + 1u) * nloc) {
            __builtin_amdgcn_fence(__ATOMIC_RELEASE, "agent");
            asm volatile("s_waitcnt vmcnt(0)" ::: "memory");
            const unsigned og = xb_add(&bar[XB_TOP], 1u);
            const unsigned tg = og / nx;
            if (og + 1u == (tg + 1u) * nx) xb_add(&bar[XB_TOPGEN], 1u);
            else XB_SPIN(xb_ld(&bar[XB_TOPGEN]) == tg, bar);
            __builtin_amdgcn_fence(__ATOMIC_ACQUIRE, "agent");
            xb_add(&bar[XB_XGEN(b.x)], 1u);
            asm volatile("s_waitcnt vmcnt(0)" ::: "memory");
        } else {
            XB_SPIN(xb_ld(&bar[XB_XGEN(b.x)]) == gen, bar);
            __builtin_amdgcn_fence(__ATOMIC_ACQUIRE, "agent");
            asm volatile("s_waitcnt vmcnt(0)" ::: "memory");
        }
    }
    __syncthreads();
}


__device__ __forceinline__ const float* in_ptr(int k) {
    const __attribute__((address_space(4))) char* p = (const __attribute__((address_space(4))) char*)__builtin_amdgcn_kernarg_segment_ptr();
    asm volatile("" : "+s"(p));
    return *(const float* const __attribute__((address_space(4)))*)(p + 8 * k);
}
struct WDesc { const float* src; bf16* dst; const float* gain; int K, N, mode; };
__device__ __forceinline__ WDesc wdesc(int i, unsigned char* ws) {
    WDesc d;
    if (i < 8) { const int l = i >> 1, w = i & 1; d.src = (w ? in_ptr(11) : in_ptr(2)) + (size_t)l * D * (2 * DFF); d.dst = (bf16*)(ws + WS_WFFI) + (size_t)i * (2 * DFF) * D; d.K = D; d.N = 2 * DFF; d.mode = 1; d.gain = (w ? in_ptr(10) : in_ptr(1)) + (size_t)l * D; }
    else if (i < 16) { const int s = i - 8, l = s >> 1, w = s & 1; d.src = (w ? in_ptr(12) : in_ptr(3)) + (size_t)l * DFF * D; d.dst = (bf16*)(ws + WS_WFFO) + (size_t)s * D * DFF; d.K = DFF; d.N = D; d.mode = 0; d.gain = nullptr; }
    else if (i < 18) { const int e = i - 16; d.src = in_ptr(5) + (size_t)e * D * AB_IN; d.dst = (bf16*)(ws + WS_WABI) + (size_t)e * AB_IN * D; d.K = D; d.N = AB_IN; d.mode = 0; d.gain = in_ptr(4) + (size_t)(2 * e) * D; }
    else if (i < 20) { const int e = i - 18; d.src = in_ptr(6) + (size_t)e * AB_OUT * D; d.dst = (bf16*)(ws + WS_WABO) + (size_t)e * D * AB_OUT; d.K = AB_OUT; d.N = D; d.mode = 0; d.gain = nullptr; }
    else if (i < 22) { const int e = i - 20; d.src = in_ptr(7) + (size_t)e * D * C_IN; d.dst = (bf16*)(ws + WS_WCI) + (size_t)e * C_IN * D; d.K = D; d.N = C_IN; d.mode = 0; d.gain = in_ptr(4) + (size_t)(2 * e + 1) * D; }
    else { const int e = i - 22; d.src = in_ptr(8) + (size_t)e * C_OUT * D; d.dst = (bf16*)(ws + WS_WCO) + (size_t)e * D * C_OUT; d.K = C_OUT; d.N = D; d.mode = 0; d.gain = nullptr; }
    return d;
}
__device__ __forceinline__ void transpose_item(const WDesc& d, LAS float* scr, int item, int lane) {
    const int nblk = d.N / 64, kb = item / nblk, nb = item - kb * nblk, k0 = 64 * kb, n0 = 64 * nb;
    const int l16 = lane & 15, lq = lane >> 4;
#pragma unroll 4
    for (int i = 0; i < 16; ++i) { const int kk = 4 * i + lq; const f32x4 v = *(const f32x4*)(d.src + (size_t)(k0 + kk) * d.N + n0 + 4 * l16);
        LAS float* s = scr + kk * 65 + 4 * l16; s[0] = v[0]; s[1] = v[1]; s[2] = v[2]; s[3] = v[3]; }
    LDS_WAIT(); asm volatile("" ::: "memory");
    const int c = lane & 7;
    f32x4 ga = {1.f, 1.f, 1.f, 1.f}, gb = ga;
    if (d.gain) { ga = *(const f32x4*)(d.gain + k0 + 8 * c); gb = *(const f32x4*)(d.gain + k0 + 8 * c + 4); }
#pragma unroll
    for (int j = 0; j < 8; ++j) { const int n = (lane >> 3) + 8 * j; const LAS float* s = scr + (8 * c) * 65 + n;
        v4u o; o.x = pk2(s[0 * 65] * ga[0], s[1 * 65] * ga[1]); o.y = pk2(s[2 * 65] * ga[2], s[3 * 65] * ga[3]); o.z = pk2(s[4 * 65] * gb[0], s[5 * 65] * gb[1]); o.w = pk2(s[6 * 65] * gb[2], s[7 * 65] * gb[3]);
        int row = n0 + n;
        if (d.mode) { const int up = row >= DFF, jj = row - up * DFF; row = (jj >> 7) * 256 + up * 128 + (jj & 127); }
        *(v4u*)(d.dst + (size_t)row * d.K + k0 + 8 * c) = o; }
    LDS_WAIT(); asm volatile("" ::: "memory");
}
__device__ __forceinline__ void phase_prologue(unsigned char* ws, LAS unsigned char* lds, int gw, int NGW, int wave, int lane) {
    asm volatile("" : "+v"(lane));
    LAS float* scr = (LAS float*)(lds + wave * 16640);
    const int cu = gw / NWAVES, ncu = NGW / NWAVES;
    for (int i = 0; i < 24; ++i) { const WDesc d = wdesc(i, ws); const int nblk = d.N / 64, nsuper = (d.K / 512) * nblk;
        for (int sit = cu; sit < nsuper; sit += ncu) { const int kb8 = sit / nblk, nb = sit - kb8 * nblk; transpose_item(d, scr, (8 * kb8 + wave) * nblk + nb, lane); } }
    const float* x = in_ptr(0); bf16* hb = (bf16*)(ws + WS_HB); float* prt = (float*)(ws + WS_PART);
    for (int row = gw; row < M; row += NGW) {
        const f32x4* xr = (const f32x4*)(x + (size_t)row * D); float sq = 0.f;
#pragma unroll
        for (int j = 0; j < 8; ++j) { const f32x4 a = xr[(lane + 64 * j) * 2], b = xr[(lane + 64 * j) * 2 + 1];
            sq += (a[0] * a[0] + a[1] * a[1]) + (a[2] * a[2] + a[3] * a[3]) + (b[0] * b[0] + b[1] * b[1]) + (b[2] * b[2] + b[3] * b[3]);
            v4u o; o.x = pk2(a[0], a[1]); o.y = pk2(a[2], a[3]); o.z = pk2(b[0], b[1]); o.w = pk2(b[2], b[3]); *((v4u*)(hb + (size_t)row * D) + lane + 64 * j) = o; }
        prt[(size_t)row * 64 + lane] = sq;
    }
}
__device__ __forceinline__ void phase_final_norm(const bf16* xb, const float* g, float* outp, int row0, int rstep, int rend, int lane) {
    asm volatile("" : "+v"(lane));
    for (int row = row0; row < rend; row += rstep) {
        const v4u* xr = (const v4u*)(xb + (size_t)row * D);
        float v[8][8]; float s = 0.f;
#pragma unroll
        for (int j = 0; j < 8; ++j) { const v4u b = xr[lane + 64 * j];
            v[j][0] = bflo(b.x); v[j][1] = bfhi(b.x); v[j][2] = bflo(b.y); v[j][3] = bfhi(b.y); v[j][4] = bflo(b.z); v[j][5] = bfhi(b.z); v[j][6] = bflo(b.w); v[j][7] = bfhi(b.w);
#pragma unroll
            for (int e = 0; e < 8; ++e) s += v[j][e] * v[j][e]; }
        const float r = 1.0f / sqrtf(wave_sum(s) * (1.0f / D) + RMS_EPS);
        const f32x4* gr = (const f32x4*)g;
#pragma unroll
        for (int j = 0; j < 8; ++j) { const f32x4 g0 = gr[(lane + 64 * j) * 2], g1 = gr[(lane + 64 * j) * 2 + 1];
            f32x4 a = {v[j][0], v[j][1], v[j][2], v[j][3]}, b = {v[j][4], v[j][5], v[j][6], v[j][7]};
            f32x4* o = (f32x4*)(outp + (size_t)row * D) + (lane + 64 * j) * 2; o[0] = a * r * g0; o[1] = b * r * g1; }
    }
}
namespace at {
typedef short bf16x8 __attribute__((ext_vector_type(8)));
typedef float f32x16 __attribute__((ext_vector_type(16)));
typedef short s16x4 __attribute__((ext_vector_type(4)));
typedef short v4i16_t __attribute__((ext_vector_type(4)));
typedef float f32x2_t __attribute__((ext_vector_type(2))); typedef __bf16 bf16x2_t __attribute__((ext_vector_type(2)));
#define ATDI __device__ __forceinline__
#define MFMA32(a, b, c) __builtin_amdgcn_mfma_f32_32x32x16_bf16((a), (b), (c), 0, 0, 0)
constexpr float LOG2E = 1.4426950408889634f, LN2 = 0.6931471805599453f;
ATDI unsigned cvtpk(float lo, float hi) { f32x2_t v = {lo, hi}; bf16x2_t b = __builtin_convertvector(v, bf16x2_t); return __builtin_bit_cast(unsigned, b); }
ATDI s16x4 vtr(LAS const char* p) { return __builtin_bit_cast(s16x4, __builtin_amdgcn_ds_read_tr16_b64_v4i16((LAS v4i16_t*)p)); }
ATDI float xmaxh(float v) { const unsigned a = __float_as_uint(v); auto r = __builtin_amdgcn_permlane32_swap(a, a, false, false); return fmaxf(__uint_as_float(r[0]), __uint_as_float(r[1])); }
ATDI float xsumh(float v) { const unsigned a = __float_as_uint(v); auto r = __builtin_amdgcn_permlane32_swap(a, a, false, false); return __uint_as_float(r[0]) + __uint_as_float(r[1]); }
ATDI float xother(float v, int h) { const unsigned a = __float_as_uint(v); auto r = __builtin_amdgcn_permlane32_swap(a, a, false, false); return h ? __uint_as_float(r[0]) : __uint_as_float(r[1]); }
template <int HD> ATDI unsigned voff(unsigned row, unsigned ch) {
    if (HD == 128) return 256u * row + 16u * (ch ^ (((row & 3u) << 2) | ((row >> 2) & 3u)));
    else return 128u * row + 16u * (ch ^ ((((row >> 1) & 1u) << 2) | ((row >> 2) & 3u)));
}
template <int HD> struct State { bf16x8 q[HD / 16]; f32x16 o[HD / 32]; float m, l; };
ATDI unsigned q_loff(int lane, unsigned rstride_bytes) { return (unsigned)(lane & 31) * rstride_bytes + 16u * (unsigned)(lane >> 5); }
template <int HD> ATDI void load_qfrags(bf16x8 (&f)[HD / 16], const char* ubase, unsigned loff) {
#pragma unroll
    for (int s = 0; s < HD / 16; ++s) f[s] = *(const bf16x8*)(ubase + loff + 32 * s);
}
template <int HD> ATDI unsigned v_loff(int lane, unsigned rstride_bytes) { constexpr int CPR = HD / 8; return (unsigned)(lane / CPR) * rstride_bytes + 16u * (unsigned)(lane % CPR); }
template <int HD> ATDI void load_v(v4u (&vr)[HD / 16], const char* ubase, unsigned rstride_bytes, unsigned loff) {
    constexpr int CPR = HD / 8, RPI = 64 / CPR;
#pragma unroll
    for (int i = 0; i < HD / 16; ++i) vr[i] = *(const v4u*)(ubase + (size_t)i * RPI * rstride_bytes + loff);
}
typedef __amdgpu_buffer_rsrc_t rsrc_t;
ATDI rsrc_t make_rsrc(const void* base, unsigned bytes) { return __builtin_amdgcn_make_buffer_rsrc((void*)base, 0, (int)bytes, 0x00020000); }
template <int HD> ATDI void load_vb(v4u (&vr)[HD / 16], rsrc_t rs, unsigned soff, unsigned rstride_bytes, unsigned loff) {
    constexpr int CPR = HD / 8, RPI = 64 / CPR;
#pragma unroll
    for (int i = 0; i < HD / 16; ++i) vr[i] = __builtin_amdgcn_raw_buffer_load_b128(rs, (int)loff, (int)(soff + (unsigned)i * RPI * rstride_bytes), 0);
}
template <int HD> ATDI void store_v(const v4u (&vr)[HD / 16], LAS char* vl, int lane) {
    constexpr int CPR = HD / 8, RPI = 64 / CPR; const int r0 = lane / CPR, ch = lane % CPR;
#pragma unroll
    for (int i = 0; i < HD / 16; ++i) *(LAS v4u*)(vl + voff<HD>((unsigned)(r0 + RPI * i), (unsigned)ch)) = vr[i];
}
template <int HD> ATDI f32x16 qk(LAS const char* kl, const bf16x8 (&qf)[HD / 16], int lane) {
    f32x16 S;
#pragma unroll
    for (int i = 0; i < 16; ++i) S[i] = 0.f;
    const unsigned r = lane & 31, h = lane >> 5;
#pragma unroll
    for (int s = 0; s < HD / 16; ++s) { const bf16x8 kf = *(LAS const bf16x8*)(kl + voff<HD>(r, 2u * s + h)); S = MFMA32(kf, qf[s], S); }
    return S;
}
template <int HD> ATDI void stash_q(LAS char* ql, const char* ubase, unsigned loff, int lane) {
    bf16x8 f[HD / 16]; load_qfrags<HD>(f, ubase, loff);
#pragma unroll
    for (int s = 0; s < HD / 16; ++s) *(LAS bf16x8*)(ql + s * 1024 + lane * 16) = f[s];
}
template <int HD> ATDI f32x16 qk_l(LAS const char* kl, LAS const char* ql, int lane) {
    f32x16 S;
#pragma unroll
    for (int i = 0; i < 16; ++i) S[i] = 0.f;
    const unsigned r = lane & 31, h = lane >> 5;
#pragma unroll
    for (int s = 0; s < HD / 16; ++s) { const bf16x8 kf = *(LAS const bf16x8*)(kl + voff<HD>(r, 2u * s + h)); const bf16x8 qf = *(LAS const bf16x8*)(ql + s * 1024 + lane * 16); S = MFMA32(kf, qf, S); }
    return S;
}
template <int HD> ATDI void pv(f32x16 (&o)[HD / 32], const float (&p)[16], LAS const char* vl, int lane) {
    const unsigned h = lane >> 5, blk = (lane >> 4) & 1, qd = (lane & 15) >> 2, pp = lane & 3;
#pragma unroll
    for (int s = 0; s < 2; ++s) {
        bf16x8 pf; { unsigned w[4];
#pragma unroll
            for (int j = 0; j < 4; ++j) w[j] = cvtpk(p[8 * s + 2 * j], p[8 * s + 2 * j + 1]);
            typedef unsigned u4 __attribute__((ext_vector_type(4))); u4 ww = {w[0], w[1], w[2], w[3]}; pf = __builtin_bit_cast(bf16x8, ww); }
#pragma unroll
        for (int db = 0; db < HD / 32; ++db) {
            const unsigned ch = 4 * db + 2 * blk + (pp >> 1);
            const s16x4 lo = vtr(vl + voff<HD>(16 * s + 4 * h + qd, ch) + 8 * (pp & 1));
            const s16x4 hi = vtr(vl + voff<HD>(16 * s + 8 + 4 * h + qd, ch) + 8 * (pp & 1));
            const bf16x8 vf = __builtin_shufflevector(lo, hi, 0, 1, 2, 3, 4, 5, 6, 7);
            o[db] = MFMA32(vf, pf, o[db]);
        }
    }
}
template <int HD> ATDI void band_tile(State<HD>& st, const f32x16& S, LAS const char* vl, int lane, int dl, float c1, float c2, int maxd, bool need_mask) {
    const f32x16 KROV = {0.f, 1.f, 2.f, 3.f, 8.f, 9.f, 10.f, 11.f, 16.f, 17.f, 18.f, 19.f, 24.f, 25.f, 26.f, 27.f};
    const float b0 = -c2 * (float)dl;
    f32x16 sc = S * c1 + (KROV * c2 + b0);
    if (need_mask) {
#pragma unroll
        for (int v = 0; v < 16; ++v) { const int kro = (v & 3) + 8 * (v >> 2); sc[v] = ((unsigned)(dl - kro) <= (unsigned)maxd) ? sc[v] : -INFINITY; }
    }
    float tmax = fmaxf(fmaxf(sc[0], sc[1]), fmaxf(sc[2], sc[3]));
#pragma unroll
    for (int v = 4; v < 16; v += 4) tmax = fmaxf(tmax, fmaxf(fmaxf(sc[v], sc[v + 1]), fmaxf(sc[v + 2], sc[v + 3])));
    tmax = xmaxh(tmax);
    if (__any(tmax > st.m)) {
        const float mnew = fmaxf(st.m, tmax), alpha = __builtin_amdgcn_exp2f(st.m - mnew); st.m = mnew; st.l *= alpha;
#pragma unroll
        for (int db = 0; db < HD / 32; ++db) st.o[db] = st.o[db] * alpha;
    }
    sc = sc - st.m;
    float p[16]; float ps = 0.f;
#pragma unroll
    for (int v = 0; v < 16; ++v) { p[v] = __builtin_amdgcn_exp2f(sc[v]); ps += p[v]; }
    st.l += ps;
    pv<HD>(st.o, p, vl, lane);
}
template <int HD> ATDI void sb_tile(State<HD>& st, const f32x16& S, LAS const char* vl, int lane, bool diag, float scale2  , float& P) {
    const int q = lane & 31, h = lane >> 5;
    float p[16], seg[4];
#pragma unroll
    for (int a = 0; a < 4; ++a) { float run = 1.f;
#pragma unroll
        for (int j = 3; j >= 0; --j) { const int v = 4 * a + j, kro = j + 8 * a + 4 * h;
            const float z = S[v] * scale2, e = __builtin_amdgcn_exp2f(-fabsf(z)), r = __builtin_amdgcn_rcpf(1.0f + e), er = e * r;
            float sig = z >= 0.f ? r : er, keep = z >= 0.f ? er : r;
            if (diag && !(kro < q)) { sig = 0.f; keep = 1.f; }
            p[v] = sig * run; run *= keep; }
        seg[a] = run; }
    float ps[4], T[4];
#pragma unroll
    for (int a = 0; a < 4; ++a) { ps[a] = xother(seg[a], h); T[a] = seg[a] * ps[a]; }
    float aft[4]; aft[3] = 1.f; aft[2] = T[3]; aft[1] = T[3] * T[2]; aft[0] = aft[1] * T[1];
    const float total = aft[0] * T[0];
#pragma unroll
    for (int a = 0; a < 4; ++a) { const float off = aft[a] * (h == 0 ? ps[a] : 1.f) * P;
#pragma unroll
        for (int j = 0; j < 4; ++j) p[4 * a + j] *= off; }
    P *= total;
    pv<HD>(st.o, p, vl, lane);
}
template <int HD> ATDI void store_out(const State<HD>& st, float inv, bf16* orow, int h) {
#pragma unroll
    for (int db = 0; db < HD / 32; ++db)
#pragma unroll
        for (int g = 0; g < 4; ++g) { typedef unsigned u2 __attribute__((ext_vector_type(2)));
            u2 w; w.x = cvtpk(st.o[db][4 * g] * inv, st.o[db][4 * g + 1] * inv); w.y = cvtpk(st.o[db][4 * g + 2] * inv, st.o[db][4 * g + 3] * inv);
            *(u2*)(orow + 32 * db + 8 * g + 4 * h) = w; }
}
template <int HD> ATDI unsigned ost_off(unsigned row, unsigned chunk) { constexpr unsigned CPR = HD / 8; return row * (HD * 2) + 16u * (chunk ^ (row & (CPR - 1))); }
template <int HD> ATDI void stage_rows_out(LAS char* stg, rsrc_t ors, unsigned soff, unsigned rstride_bytes, int lane) {
    constexpr int CPR = HD / 8, RPI = 64 / CPR; const unsigned r0 = lane / CPR, cc = lane % CPR, voff_ = r0 * rstride_bytes + 16u * cc;
#pragma unroll
    for (int i = 0; i < HD / 16; ++i) { const v4u v = *(LAS const v4u*)(stg + ost_off<HD>(r0 + RPI * i, cc)); __builtin_amdgcn_raw_buffer_store_b128(v, ors, (int)voff_, (int)(soff + (unsigned)i * RPI * rstride_bytes), 0); }
}
template <int HD> ATDI void stage_rows_in(LAS char* stg, rsrc_t ors, unsigned soff, unsigned rstride_bytes, int lane) {
    constexpr int CPR = HD / 8, RPI = 64 / CPR; const unsigned r0 = lane / CPR, cc = lane % CPR, voff_ = r0 * rstride_bytes + 16u * cc;
#pragma unroll
    for (int ib = 0; ib < HD / 16; ib += 4) {
        v4u v[4];
#pragma unroll
        for (int i = 0; i < 4; ++i) v[i] = __builtin_amdgcn_raw_buffer_load_b128(ors, (int)voff_, (int)(soff + (unsigned)(ib + i) * RPI * rstride_bytes), 0);
#pragma unroll
        for (int i = 0; i < 4; ++i) *(LAS v4u*)(stg + ost_off<HD>(r0 + RPI * (ib + i), cc)) = v[i];
        asm volatile("" ::: "memory");
    }
}
template <int HD> ATDI void store_out_rows(const State<HD>& st, float inv, LAS char* stg, rsrc_t ors, unsigned soff, unsigned rstride_bytes, int lane) {
    const unsigned q = lane & 31, h = lane >> 5; typedef unsigned u2 __attribute__((ext_vector_type(2)));
#pragma unroll
    for (int db = 0; db < HD / 32; ++db)
#pragma unroll
        for (int g = 0; g < 4; ++g) { u2 w; w.x = cvtpk(st.o[db][4 * g] * inv, st.o[db][4 * g + 1] * inv); w.y = cvtpk(st.o[db][4 * g + 2] * inv, st.o[db][4 * g + 3] * inv);
            *(LAS u2*)(stg + ost_off<HD>(q, 4 * db + g) + 8 * h) = w; }
    stage_rows_out<HD>(stg, ors, soff, rstride_bytes, lane);
}
template <int HD> ATDI void zero_o(State<HD>& st) {
#pragma unroll
    for (int db = 0; db < HD / 32; ++db)
#pragma unroll
        for (int i = 0; i < 16; ++i) st.o[db][i] = 0.f;
}

struct CPos { int u, kt; };
ATDI int c_ktlo(int u) { const int qt = u & 127; return qt - 4 > 0 ? qt - 4 : 0; }
ATDI CPos c_next(CPos p, int G) { CPos n; if (p.kt > c_ktlo(p.u)) { n.u = p.u; n.kt = p.kt - 1; } else { n.u = p.u + G; n.kt = n.u & 127; } return n; }
ATDI const char* c_tile(const bf16* qkv, CPos p) { const int hk = (p.u >> 7) & 7, b = p.u >> 10; return (const char*)(qkv + ((size_t)(64 + hk) * M + (size_t)b * SEQ + 32 * p.kt) * 64); }
ATDI const char* c_qrow(const bf16* qkv, int u, int wave) { const int qt = u & 127, hk = (u >> 7) & 7, b = u >> 10; return (const char*)(qkv + ((size_t)(8 * hk + wave) * M + (size_t)b * SEQ + 32 * qt) * 64); }
template <int MODE = 0> ATDI void phase_attn_c(const bf16* qkv, const float* sinks, bf16* ao, LAS unsigned char* lds, int vcu  , int G  , int C_NU  , int wave, int lane) {
    asm volatile("" : "+v"(lane));
    constexpr int HD = 64;
    const int q = lane & 31, h = lane >> 5;
    const unsigned qloff = q_loff(lane, 128);
    const int isv = wave >> 2, idx = 64 * (wave & 3) + lane, prow = idx >> 3, pch = idx & 7;
    const unsigned src_off = (unsigned)prow * 128u + 16u * (unsigned)pch + (isv ? (unsigned)((size_t)8 * M * 128) : 0u);
    const unsigned dst_off = (isv ? 4096u : 0u) + voff<HD>((unsigned)prow, (unsigned)pch);
    const float c1 = 0.125f * LOG2E;
    const rsrc_t ors = make_rsrc(ao, (unsigned)((size_t)M * C_OUT * 2));
    if (vcu >= C_NU) return;
    State<HD> st; float c2 = 0.f; bf16x8 qn[4];
    CPos p0; p0.u = vcu; p0.kt = vcu & 127; CPos p1 = c_next(p0, G);
    v4u r = *(const v4u*)(c_tile(qkv, p0) + src_off);
    *(LAS v4u*)((LAS char*)lds + dst_off) = r;
    r = *(const v4u*)(c_tile(qkv, p1.u < C_NU ? p1 : p0) + src_off);
    load_qfrags<HD>(qn, c_qrow(qkv, p0.u, wave), qloff);
    asm volatile("s_waitcnt lgkmcnt(0)" ::: "memory"); __builtin_amdgcn_s_barrier(); asm volatile("" ::: "memory");
    for (int t = 0; p0.u < C_NU; ++t) {
        const int ln = lane;
        LAS char* cur = (LAS char*)lds + (t & 1) * 8192; LAS char* nxt = (LAS char*)lds + ((t + 1) & 1) * 8192;
        const CPos p2 = c_next(p1, G);
        const int qt = p0.u & 127, hq = __builtin_amdgcn_readfirstlane(8 * ((p0.u >> 7) & 7) + wave);
        *(LAS v4u*)(nxt + dst_off) = r;
        if (MODE != 2) r = *(const v4u*)(c_tile(qkv, p2.u < C_NU ? p2 : p0) + src_off);
        if (p0.kt == qt) {
#pragma unroll
            for (int s_ = 0; s_ < 4; ++s_) st.q[s_] = qn[s_];
            const float sk = sinks[hq];
            zero_o<HD>(st); st.m = sk * LOG2E; st.l = (h == 0) ? 1.0f : 0.0f; c2 = __builtin_amdgcn_exp2f(-(float)(hq + 1) * 0.125f) * LOG2E;
            const int un = p0.u + G; load_qfrags<HD>(qn, c_qrow(qkv, un < C_NU ? un : p0.u, wave), qloff);
        }
        if (MODE != 1) { const f32x16 S = qk<HD>(cur, st.q, ln);
        band_tile<HD>(st, S, cur + 4096, ln, 32 * (qt - p0.kt) + q - 4 * h, c1, c2, 127, (p0.kt == qt) || (qt - p0.kt == 4)); }
        if (MODE != 3 && p0.kt == c_ktlo(p0.u)) { const float l = xsumh(st.l); int lo_ = lane; asm volatile("" : "+v"(lo_));
            store_out_rows<HD>(st, 1.0f / l, (LAS char*)lds + 16384 + wave * 4096, ors, (unsigned)((((size_t)(p0.u >> 10) * SEQ + 32 * qt) * C_OUT + hq * 64) * 2), C_OUT * 2, lo_); }
        asm volatile("s_waitcnt lgkmcnt(0)" ::: "memory"); __builtin_amdgcn_s_barrier(); asm volatile("" ::: "memory");
        p0 = p1; p1 = p2;
    }
}
template <int HD> ATDI void a_pass(State<HD>& st, const char* qbase, unsigned qloff, rsrc_t rs, unsigned kb  , unsigned vofs  , unsigned rsb, int Q0, int qstep, float c2,
                                   LAS char* kl  , LAS char* vl  , int lane) {
    const int q = lane & 31, h = lane >> 5;
    const float c1 = 0.08838834764831845f * LOG2E;
    load_qfrags<HD>(st.q, qbase, qloff);
    int kt_lo = (Q0 - 128) >> 5; if (kt_lo < 0) kt_lo = 0; const int kt_hi = (Q0 + 31 * qstep) >> 5;
    const unsigned vloff = v_loff<HD>(lane, rsb);
    v4u kr[HD / 16], vr[HD / 16];
    load_vb<HD>(kr, rs, kb + (unsigned)(32 * kt_hi) * rsb, rsb, vloff); load_vb<HD>(vr, rs, kb + vofs + (unsigned)(32 * kt_hi) * rsb, rsb, vloff);
    for (int kt = kt_hi; kt >= kt_lo; --kt) {
        int ln = lane; asm volatile("" : "+v"(ln));
        float c2t = c2; asm volatile("" : "+v"(c2t));
        store_v<HD>(kr, kl, ln); store_v<HD>(vr, vl, ln);
        if (kt > kt_lo) { load_vb<HD>(kr, rs, kb + (unsigned)(32 * (kt - 1)) * rsb, rsb, vloff); load_vb<HD>(vr, rs, kb + vofs + (unsigned)(32 * (kt - 1)) * rsb, rsb, vloff); }
        const f32x16 S = qk<HD>(kl, st.q, ln);
        const int D0 = Q0 - 32 * kt; band_tile<HD>(st, S, vl, ln, D0 + qstep * q - 4 * h, c1, c2t, 128, (D0 < 31) || (D0 + 31 * qstep > 128));
    }
}
ATDI float a_slope2(int head, int r) { return __builtin_amdgcn_exp2f(-(float)(head + 1) * (1.0f / 3.0f)) * (float)r * LOG2E; }
ATDI void phase_attn_a(const bf16* qkv, bf16* ao, LAS unsigned char* lds, int vcu, int G, int wave, int lane) {
    asm volatile("" : "+v"(lane));
    constexpr int HD = 128; LAS char* kl = (LAS char*)lds + wave * 16384; LAS char* vl = kl + 8192;
    typedef float f32x2v __attribute__((ext_vector_type(2)));
    LAS f32x2v* ML = (LAS f32x2v*)((LAS char*)lds + 131072);
    const int q = lane & 31, h = lane >> 5;
    const rsrc_t rs = make_rsrc(qkv, (unsigned)((size_t)M * AB_IN * 2));
    constexpr unsigned AVOFS = (unsigned)((size_t)24 * M * 256);
    for (int wgu = vcu; wgu < BATCH * 8 * 8; wgu += G) {
        const int ch = wgu & 7, hs = (wgu >> 3) & 7, b = wgu >> 6;
        const size_t tokb = (size_t)b * SEQ;
#pragma unroll 1
        for (int bi = 0; bi < 2; ++bi) {
            const int blk = wave + 8 * bi, T0 = 512 * ch + 32 * blk;
            State<HD> st; zero_o<HD>(st); st.m = -1e30f; st.l = 0.f;
            a_pass<HD>(st, (const char*)(qkv + ((size_t)hs * M + tokb + T0) * 128), q_loff(lane, 256), rs, (unsigned)((((size_t)(24 + hs)) * M + tokb) * 256), AVOFS, 256u, T0, 1, a_slope2(hs, 1), kl, vl, lane);
            const float l0 = xsumh(st.l);
            store_out<HD>(st, 1.0f, ao + (tokb + T0 + q) * AB_OUT + hs * 128, h);
            if (h == 0) ML[32 * blk + q] = (f32x2v){st.m, l0};
        }
        asm volatile("s_waitcnt vmcnt(0)" ::: "memory"); __syncthreads();
#pragma unroll 1
        for (int ci = 0; ci < 2; ++ci) {
            const int c = wave + 8 * ci, tq0 = 512 * ch + c;
            State<HD> st; zero_o<HD>(st); st.m = -1e30f; st.l = 0.f;
            const unsigned qloff = q_loff(lane, 16 * 256);
#pragma unroll 1
            for (int g = 1; g < 3; ++g) { const int head = 8 * g + hs, sh = 2 * g, r = 1 << sh, cr = c & (r - 1);
                a_pass<HD>(st, (const char*)(qkv + ((size_t)head * M + tokb + tq0) * 128), qloff, rs, (unsigned)((((size_t)(24 + head)) * M + tokb + cr) * 256), AVOFS, (unsigned)r * 256u,
                           (512 >> sh) * ch + (c >> sh), 16 >> sh, a_slope2(head, r), kl, vl, lane); }
            const float l12 = xsumh(st.l);
            const f32x2v ml = ML[c + 16 * q];
            const float mt = fmaxf(st.m, ml.x), a12 = __builtin_amdgcn_exp2f(st.m - mt), a0 = __builtin_amdgcn_exp2f(ml.x - mt);
            const float inv = 1.0f / (l12 * a12 + ml.y * a0), w12 = a12 * inv, w0 = a0 * inv;
            bf16* orow = ao + (tokb + tq0 + 16 * q) * AB_OUT + hs * 128;
#pragma unroll
            for (int db = 0; db < HD / 32; ++db)
#pragma unroll
                for (int g4 = 0; g4 < 4; ++g4) { typedef unsigned u2 __attribute__((ext_vector_type(2)));
                    u2* p = (u2*)(orow + 32 * db + 8 * g4 + 4 * h); const u2 o0 = *p;
                    const float r0 = st.o[db][4 * g4] * w12 + bflo(o0.x) * w0, r1 = st.o[db][4 * g4 + 1] * w12 + bfhi(o0.x) * w0;
                    const float r2 = st.o[db][4 * g4 + 2] * w12 + bflo(o0.y) * w0, r3 = st.o[db][4 * g4 + 3] * w12 + bfhi(o0.y) * w0;
                    u2 w; w.x = cvtpk(r0, r1); w.y = cvtpk(r2, r3); *p = w; }
        }
        asm volatile("s_waitcnt vmcnt(0)" ::: "memory"); __syncthreads();
    }
}
ATDI void phase_attn_b(const bf16* qkv, bf16* ao, LAS unsigned char* lds, int wu0, int wstep, int wend, int wave, int lane) {
    asm volatile("" : "+v"(lane));
    constexpr int HD = 128; LAS char* kvl = (LAS char*)lds + wave * 16384; LAS char* ql = kvl + 8192;
    const int q = lane & 31, h = lane >> 5;
    const unsigned qloff = q_loff(lane, 256), vloff = v_loff<HD>(lane, 256);
    const rsrc_t rs = make_rsrc(qkv, (unsigned)((size_t)M * AB_IN * 2));
    const rsrc_t ors = make_rsrc(ao, (unsigned)((size_t)M * AB_OUT * 2));
    constexpr unsigned BVOFS = (unsigned)((size_t)8 * M * 256);
    for (int wu = wu0; wu < wend; wu += wstep) {
        const int qt = wu & 127, hs = (wu >> 7) & 7, b = wu >> 10;
        const size_t tokb = (size_t)b * SEQ;
        State<HD> st; zero_o<HD>(st); stash_q<HD>(ql, (const char*)(qkv + ((size_t)(72 + hs) * M + tokb + 32 * qt) * 128), qloff, lane);
        float P = 1.f;
        const unsigned kb = (unsigned)(((size_t)(80 + hs) * M + tokb) * 256);
        v4u kr[HD / 16], vr[HD / 16];
        load_vb<HD>(kr, rs, kb + (unsigned)(32 * qt) * 256u, 256u, vloff); load_vb<HD>(vr, rs, kb + BVOFS + (unsigned)(32 * qt) * 256u, 256u, vloff);
        for (int kt = qt; kt >= 0; --kt) {
            store_v<HD>(kr, kvl, lane);
            if (kt > 0) load_vb<HD>(kr, rs, kb + (unsigned)(32 * (kt - 1)) * 256u, 256u, vloff);
            const f32x16 S = qk_l<HD>(kvl, ql, lane);
            store_v<HD>(vr, kvl, lane);
            if (kt > 0) load_vb<HD>(vr, rs, kb + BVOFS + (unsigned)(32 * (kt - 1)) * 256u, 256u, vloff);
            sb_tile<HD>(st, S, kvl, lane, kt == qt, 0.08838834764831845f * LOG2E, P);
            if (__all(P < 1e-37f)) break;
        }
        store_out_rows<HD>(st, 1.0f, kvl, ors, (unsigned)(((tokb + 32 * qt) * AB_OUT + 1024 + hs * 128) * 2), AB_OUT * 2, lane);
    }
}
}


struct Args { const float* in[14]; float* out; unsigned char* ws; int ph_lo, ph_hi, li, pad; };
constexpr int GRP_WGS = 64, GRID_WGS = 4 * GRP_WGS;
__global__ void __launch_bounds__(NWAVES * 64, 2) fwd_kernel(Args args) {
    extern __shared__ __attribute__((aligned(16))) unsigned char lds_raw[];
    LAS unsigned char* lds = (LAS unsigned char*)lds_raw;
    volatile LAS unsigned* MISC = (volatile LAS unsigned*)(lds + MISC_OFF);
    const int wave = __builtin_amdgcn_readfirstlane((int)threadIdx.x >> 6);
#define LANE_ID() ((int)__builtin_amdgcn_mbcnt_hi(~0u, __builtin_amdgcn_mbcnt_lo(~0u, 0u)))
    const int G = gridDim.x, bx = blockIdx.x, vcu = (bx % 8) * (G / 8) + bx / 8;
    const int gw = vcu * NWAVES + wave, NGW = G * NWAVES;
    const int bb = (bx & 7) >> 1, xl = bx & 1, cl = bx >> 3, gci = xl * 32 + cl;
    unsigned char* ws = args.ws;
    unsigned* ctl = (unsigned*)(ws + WS_CTL);
    for (int u = wave * 64 + LANE_ID(); u < (LDS_BYTES - LDSCTL_OFF) / 4; u += NWAVES * 64) ((LAS unsigned*)(lds + LDSCTL_OFF))[u] = 0u;
    __syncthreads();
    const XcdBarrier bar0 = xcd_barrier_post(ctl + CW_BAR, MISC + 8, wave, (unsigned)G);
    const XcdBarrier bar = xcd_barrier_post(ctl + CW_BAR + (1 + bb) * XCD_BAR_WORDS, MISC + 12, wave, (unsigned)GRP_WGS);

    bf16* HB = (bf16*)(ws + WS_HB); bf16* ACT = (bf16*)(ws + WS_ACT); bf16* QKV = (bf16*)(ws + WS_QKV); bf16* AO = (bf16*)(ws + WS_AO);

    phase_prologue(ws, lds, gw, NGW, wave, LANE_ID());
    xcd_barrier(bar0);

    float* PART = (float*)(ws + WS_PART);
    LAS float* rtab = (LAS float*)(lds + RINV_OFF);
    int rs = 0;
#pragma unroll 1
    for (int s = 0; s < 8; ++s) {
        const int l = s >> 1, second = s & 1;
        { pg8::Gemm g{HB, (const bf16*)(ws + WS_WFFI) + (size_t)s * (2 * DFF) * D, M, 2 * DFF, D}; pg8::GroupOrder S; S.init(2 * DFF, 16 * bb + 8 * xl, cl, wave);
          const float* prt = PART + (size_t)rs * M * 64; pg8::rinv_panel(prt, S.pm0, rtab, wave); if (S.mode8) pg8::rinv_panel(prt, S.pm0 + 4, rtab + 256, wave);
          pg8::EpiSwiglu E{ACT, DFF, pg8::RowScale{rtab, S.pm0, prt}};
          pg8::gemm_phase<pg8::EpiSwiglu, pg8::GroupOrder, PG8_ALIGN, PG8_SP2>(lds + RING_OFF, g, S, E); }
        xcd_barrier(bar);
        { pg8::Gemm g{ACT, (const bf16*)(ws + WS_WFFO) + (size_t)s * D * DFF, M, D, DFF}; pg8::GroupOrder S; S.init(D, 16 * bb + 8 * xl, cl, wave);
          pg8::EpiResid E{HB, PART + (size_t)(rs + 1) * M * 64, D, 0.5f};
          pg8::gemm_phase<pg8::EpiResid, pg8::GroupOrder, PG8_ALIGN, PG8_SP2>(lds + RING_OFF, g, S, E); }
        xcd_barrier(bar);
        ++rs;
        if (second && s != 7) xcd_barrier(bar0);
        if (!second) {
            const int e = l >> 1, isC = l & 1;
            { const int N = isC ? C_IN : AB_IN;
              const bf16* Wt = isC ? (const bf16*)(ws + WS_WCI) + (size_t)e * C_IN * D : (const bf16*)(ws + WS_WABI) + (size_t)e * AB_IN * D;
              pg8::Gemm g{HB, Wt, M, N, D}; pg8::GroupOrder S; S.init(N, 16 * bb + 8 * xl, cl, wave);
              const float* prt = PART + (size_t)rs * M * 64; pg8::rinv_panel(prt, S.pm0, rtab, wave); if (S.mode8) pg8::rinv_panel(prt, S.pm0 + 4, rtab + 256, wave);
              if (isC) { pg8::EpiHeads<64> E{QKV, M, pg8::RowScale{rtab, S.pm0, prt}}; pg8::gemm_phase<pg8::EpiHeads<64>, pg8::GroupOrder, PG8_ALIGN, PG8_SP2>(lds + RING_OFF, g, S, E); }
              else { pg8::EpiHeads<128> E{QKV, M, pg8::RowScale{rtab, S.pm0, prt}}; pg8::gemm_phase<pg8::EpiHeads<128>, pg8::GroupOrder, PG8_ALIGN, PG8_SP2>(lds + RING_OFF, g, S, E); } }
            xcd_barrier(bar);
            if (isC) at::phase_attn_c<0>(QKV, in_ptr(9) + e * 64, AO, lds, bb * 1024 + gci, GRP_WGS, (bb + 1) * 1024, wave, LANE_ID());
            else { at::phase_attn_a(QKV, AO, lds, bb * 64 + gci, GRID_WGS, wave, LANE_ID());
                   at::phase_attn_b(QKV, AO, lds, bb * 1024 + gci * NWAVES + wave, GRP_WGS * NWAVES, (bb + 1) * 1024, wave, LANE_ID()); }
            xcd_barrier(bar);
            { const int K = isC ? C_OUT : AB_OUT;
              const bf16* Wt = isC ? (const bf16*)(ws + WS_WCO) + (size_t)e * D * C_OUT : (const bf16*)(ws + WS_WABO) + (size_t)e * D * AB_OUT;
              pg8::Gemm g{AO, Wt, M, D, K}; pg8::GroupOrder S; S.init(D, 16 * bb + 8 * xl, cl, wave);
              pg8::EpiResid E{HB, PART + (size_t)(rs + 1) * M * 64, D, 1.0f};
              pg8::gemm_phase<pg8::EpiResid, pg8::GroupOrder, PG8_ALIGN, PG8_SP2>(lds + RING_OFF, g, S, E); }
            xcd_barrier(bar);
            ++rs;
        }
    }
    phase_final_norm(HB, in_ptr(13), (float*)in_ptr(14), bb * SEQ + gci * NWAVES + wave, GRP_WGS * NWAVES, (bb + 1) * SEQ, LANE_ID());
#undef LANE_ID
}

extern "C" void kernel_launch(void* const* d_in, const int* in_sizes, int n_in, void* d_out, int out_size, void* d_ws, size_t ws_size, hipStream_t stream) {
    static int grid = 0;
    if (grid == 0) {
        if (n_in != 14 || in_sizes[0] != M * D || out_size != M * D || ws_size < WS_END) { fprintf(stderr, "kernel_launch: unexpected shapes (n_in %d, in0 %d, out %d, ws %zu < %zu); nothing launched\n", n_in, n_in > 0 ? in_sizes[0] : -1, out_size, ws_size, (size_t)WS_END); grid = -1; return; }
        int dev = 0, cus = 0, per_cu = 0;
        if (hipGetDevice(&dev) != hipSuccess || hipDeviceGetAttribute(&cus, hipDeviceAttributeMultiprocessorCount, dev) != hipSuccess) { fprintf(stderr, "kernel_launch: device query failed\n"); grid = -1; return; }
        if (hipFuncSetAttribute((const void*)fwd_kernel, hipFuncAttributeMaxDynamicSharedMemorySize, LDS_BYTES) != hipSuccess) { fprintf(stderr, "kernel_launch: hipFuncSetAttribute failed\n"); grid = -1; return; }
        if (hipOccupancyMaxActiveBlocksPerMultiprocessor(&per_cu, (const void*)fwd_kernel, NWAVES * 64, LDS_BYTES) != hipSuccess || per_cu < 1) fprintf(stderr, "kernel_launch: note: occupancy query reports %d workgroups per CU\n", per_cu);
        (void)hipGetLastError();
        if (cus != GRID_WGS) { fprintf(stderr, "kernel_launch: this kernel is laid out for %d CUs with one resident workgroup each (found %d CUs, %d workgroups per CU); nothing launched\n", GRID_WGS, cus, per_cu); grid = -1; return; }
        grid = GRID_WGS;
    }
    if (grid < 0) return;
    if (hipMemsetAsync((char*)d_ws + WS_CTL, 0, CTL_ZERO_BYTES, stream) != hipSuccess) { fprintf(stderr, "kernel_launch: memset failed\n"); return; }
    Args a{};
    for (int i = 0; i < 14; ++i) a.in[i] = (const float*)d_in[i];
    a.out = (float*)d_out; a.ws = (unsigned char*)d_ws;
    a.ph_lo = 0; a.ph_hi = N_PHASES; a.li = 0;
    hipLaunchKernelGGL(fwd_kernel, dim3(grid), dim3(NWAVES * 64), LDS_BYTES, stream, a);
    const hipError_t le = hipPeekAtLastError();
    if (le != hipSuccess) fprintf(stderr, "kernel_launch: launch failed: %s\n", hipGetErrorName(le));
}
```

```cpp
#include <hip/hip_runtime.h>
#include <cstdio>
#include <cstdint>

namespace pg8 {
#define PG8_LAS __attribute__((address_space(3)))
typedef unsigned short bf16_t;
typedef short bf16x8 __attribute__((ext_vector_type(8)));
typedef float f32x4 __attribute__((ext_vector_type(4)));
typedef unsigned u32x4 __attribute__((ext_vector_type(4)));
constexpr int BM = 256, BK = 64, HALF = 128, HTB = HALF * BK * 2  , STAGE_BYTES = 8 * HTB, NXCD = 8, WGM = 8;

__host__ __device__ __forceinline__ int lds_byte(int r, int c) { const int st = (r >> 4) * 2 + (c >> 5), rr = r & 15, cc = c & 31, ob = rr * 64 + cc * 2; return st * 1024 + (ob ^ (((ob >> 9) & 1) << 5)); }
__host__ __device__ __forceinline__ void stage_rc(int b, int& R, int& C) { const int st = b / 1024, sb = b % 1024, swz = sb ^ (((sb >> 9) & 1) << 5); R = (st >> 1) * 16 + swz / 64; C = (st & 1) * 32 + (swz % 64) / 2; }
__host__ __device__ __forceinline__ int perm32(int rho) { const int n = rho >> 4, i = rho & 15; return 8 * (i >> 2) + 4 * n + (i & 3); }

struct Unit { int pm, pn; };
struct Gemm { const bf16_t* A; const bf16_t* Bt; int M, N, K; };

struct StaticOrder {
    int nM, nN, nwg, G, c, wave;
    __host__ __device__ void init(int M, int N, int G_, int c_, int wave_ = 0) { nM = M / BM; nN = N / BM; nwg = nM * nN; G = G_; c = c_; wave = wave_; }
    __host__ __device__ bool next(int i, Unit& u) const {
        const long L = (long)i * G + c; if (L >= nwg) return false;
        int wgid = (int)L; { const int q = nwg / NXCD, r = nwg % NXCD, xcd = wgid % NXCD, off = wgid / NXCD; wgid = (xcd < r ? xcd * (q + 1) : r * (q + 1) + (xcd - r) * q) + off; }
        const int nig = WGM * nN, gid = wgid / nig, fm = gid * WGM, gsz = (nM - fm) < WGM ? (nM - fm) : WGM;
        u.pm = fm + ((wgid % nig) % gsz); u.pn = (wgid % nig) / gsz; return true;
    }
    __device__ __forceinline__ void a_ready(const Unit&) const {}
    __device__ __forceinline__ void done(const Unit&) const {}
};

struct GroupOrder {
    int nU, mode8, pm0, pnb, wave;
    __host__ __device__ void init(int N, int base, int cl, int wave_) { const int nN = N / BM; nU = nN / 4; mode8 = (nN % 8 == 0); pm0 = base + (mode8 ? (cl & 3) : (cl & 7)); pnb = mode8 ? (cl >> 2) : (cl >> 3); wave = wave_; }
    __device__ __forceinline__ bool next(int i, Unit& u) const { if (i >= nU) return false; int p = mode8 ? pm0 + 4 * (i & 1) : pm0; asm volatile("" : "+s"(p)); u.pm = p; u.pn = mode8 ? 8 * (i >> 1) + pnb : 4 * i + pnb; return true; }
    __device__ __forceinline__ void a_ready(const Unit&) const {}
    __device__ __forceinline__ void done(const Unit&) const {}
};

__device__ __forceinline__ unsigned cvt_pk_bf16(float lo, float hi) { unsigned r; asm volatile("v_cvt_pk_bf16_f32 %0, %1, %2" : "=v"(r) : "v"(lo), "v"(hi)); return r; }

typedef float f32x2 __attribute__((ext_vector_type(2)));
__device__ __forceinline__ float silu_f(float g) { return g * __builtin_amdgcn_rcpf(1.0f + __builtin_amdgcn_exp2f(-1.44269504089f * g)); }
constexpr float K_NORM_INV = 1.0f / 4096.0f, K_NORM_EPS = 1e-6f;
constexpr int NPART = 64;
struct RowScale {
    PG8_LAS const float* tab; int pm0; const float* part;
    __device__ __forceinline__ float get(int pm, int r  ) const { return tab[(pm != pm0 ? 256 : 0) + r]; }
};
__device__ __forceinline__ void rinv_panel(const float* part, int pm, PG8_LAS float* tab, int wave) {
    const int tid = wave * 64 + (int)__builtin_amdgcn_mbcnt_hi(~0u, __builtin_amdgcn_mbcnt_lo(~0u, 0u));
    const int r = tid >> 1, hf = tid & 1; const f32x4* p = (const f32x4*)(part + (size_t)(pm * BM + r) * NPART + hf * 32);
    f32x4 a = p[0];
#pragma unroll
    for (int i = 1; i < 8; ++i) a += p[i];
    float sm = (a[0] + a[1]) + (a[2] + a[3]); sm += __shfl_xor(sm, 1);
    if (hf == 0) tab[r] = __builtin_amdgcn_rsqf(sm * K_NORM_INV + K_NORM_EPS);
    __syncthreads();
}
template <int HD> struct EpiHeads {
    static constexpr bool PERM = true, AFTER_DRAIN = false;
    bf16_t* O; int mtot; RowScale rsc;
    __device__ __forceinline__ void operator()(const f32x4 (&acc)[2][2][4][2], const Unit& u, int wr, int wc, int fr, int fq) const {
        const int row0 = u.pm * BM + wr * 64 + fr;
#pragma unroll
        for (int ai = 0; ai < 2; ++ai)
#pragma unroll
            for (int m = 0; m < 4; ++m) { const int row = row0 + ai * HALF + m * 16; const float ri = rsc.get(u.pm, row - u.pm * BM);
#pragma unroll
                for (int bj = 0; bj < 2; ++bj) { const f32x4 v0 = acc[ai][bj][m][0] * ri, v1 = acc[ai][bj][m][1] * ri;
                    const int tcol = bj * HALF + wc * 32 + 8 * fq;
                    const int head = u.pn * (BM / HD) + tcol / HD, hcol = tcol % HD;
                    u32x4 w; w.x = cvt_pk_bf16(v0[0], v0[1]); w.y = cvt_pk_bf16(v0[2], v0[3]); w.z = cvt_pk_bf16(v1[0], v1[1]); w.w = cvt_pk_bf16(v1[2], v1[3]);
                    *(u32x4*)(O + ((size_t)head * mtot + row) * HD + hcol) = w; } }
    }
};
struct EpiSwiglu {
    static constexpr bool PERM = true, AFTER_DRAIN = false;
    bf16_t* O; int ldc; RowScale rsc;
    __device__ __forceinline__ void operator()(const f32x4 (&acc)[2][2][4][2], const Unit& u, int wr, int wc, int fr, int fq) const {
        const int row0 = u.pm * BM + wr * 64 + fr, col0 = u.pn * HALF + wc * 32 + 8 * fq;
#pragma unroll
        for (int ai = 0; ai < 2; ++ai)
#pragma unroll
            for (int m = 0; m < 4; ++m) { const int row = row0 + ai * HALF + m * 16; bf16_t* rowp = O + (size_t)row * ldc + col0; const float ri = rsc.get(u.pm, row - u.pm * BM);
                const float na = ri * -1.44269504089f, ri2 = ri * ri;
                const f32x4 g0 = acc[ai][0][m][0], g1 = acc[ai][0][m][1], u0 = acc[ai][1][m][0], u1 = acc[ai][1][m][1];
                f32x4 t0 = g0 * na, t1 = g1 * na;
#pragma unroll
                for (int j = 0; j < 4; ++j) { t0[j] = __builtin_amdgcn_exp2f(t0[j]); t1[j] = __builtin_amdgcn_exp2f(t1[j]); }
                t0 = t0 + 1.0f; t1 = t1 + 1.0f;
#pragma unroll
                for (int j = 0; j < 4; ++j) { t0[j] = __builtin_amdgcn_rcpf(t0[j]); t1[j] = __builtin_amdgcn_rcpf(t1[j]); }
                const f32x4 h0 = (g0 * u0) * ri2 * t0, h1 = (g1 * u1) * ri2 * t1;
                u32x4 w; w.x = cvt_pk_bf16(h0[0], h0[1]); w.y = cvt_pk_bf16(h0[2], h0[3]); w.z = cvt_pk_bf16(h1[0], h1[1]); w.w = cvt_pk_bf16(h1[2], h1[3]);
                *(u32x4*)rowp = w; }
    }
};
struct EpiResid {
    static constexpr bool PERM = true, AFTER_DRAIN = false;
    bf16_t* xb; float* part; int ldc; float scale;
    __device__ __forceinline__ void operator()(const f32x4 (&acc)[2][2][4][2], const Unit& u, int wr, int wc, int fr, int fq) const {
        const int row0 = u.pm * BM + wr * 64 + fr, col0 = u.pn * BM + wc * 32 + 8 * fq;
#pragma unroll
        for (int ai = 0; ai < 2; ++ai) {
        u32x4 bs[4][2];
#pragma unroll
            for (int m = 0; m < 4; ++m) { const size_t off = (size_t)(row0 + ai * HALF + m * 16) * ldc + col0;
#pragma unroll
                for (int bj = 0; bj < 2; ++bj) bs[m][bj] = *(const u32x4*)(xb + off + bj * HALF); }
#pragma unroll
            for (int m = 0; m < 4; ++m) { const int row = row0 + ai * HALF + m * 16; const size_t off = (size_t)row * ldc + col0; float ss = 0.f;
#pragma unroll
                for (int bj = 0; bj < 2; ++bj) { const u32x4 b = bs[m][bj]; f32x4 v0, v1;
                    v0[0] = __builtin_bit_cast(float, b.x << 16); v0[1] = __builtin_bit_cast(float, b.x & 0xffff0000u); v0[2] = __builtin_bit_cast(float, b.y << 16); v0[3] = __builtin_bit_cast(float, b.y & 0xffff0000u);
                    v1[0] = __builtin_bit_cast(float, b.z << 16); v1[1] = __builtin_bit_cast(float, b.z & 0xffff0000u); v1[2] = __builtin_bit_cast(float, b.w << 16); v1[3] = __builtin_bit_cast(float, b.w & 0xffff0000u);
                    v0 = v0 + acc[ai][bj][m][0] * scale; v1 = v1 + acc[ai][bj][m][1] * scale;
                    u32x4 w; w.x = cvt_pk_bf16(v0[0], v0[1]); w.y = cvt_pk_bf16(v0[2], v0[3]); w.z = cvt_pk_bf16(v1[0], v1[1]); w.w = cvt_pk_bf16(v1[2], v1[3]);
                    *(u32x4*)(xb + off + bj * HALF) = w;
                    ss += (v0[0] * v0[0] + v0[1] * v0[1]) + (v0[2] * v0[2] + v0[3] * v0[3]) + (v1[0] * v1[0] + v1[1] * v1[1]) + (v1[2] * v1[2] + v1[3] * v1[3]); }
                ss += __shfl_xor(ss, 16); ss += __shfl_xor(ss, 32);
                if (fq == 0) part[(size_t)row * NPART + u.pn * 4 + wc] = ss; }
            asm volatile("" ::: "memory"); }
    }
};


template <class Epi, class Sched, bool ALIGN_EPI = false, bool SP2 = false>
__device__ __forceinline__ void gemm_phase(PG8_LAS unsigned char* lds, const Gemm g, const Sched& S, const Epi& E) {
    int lane_l = (int)__builtin_amdgcn_mbcnt_hi(~0u, __builtin_amdgcn_mbcnt_lo(~0u, 0u)); asm volatile("" : "+v"(lane_l));
    const int wid = __builtin_amdgcn_readfirstlane(S.wave), lane = lane_l, tid = wid * 64 + lane, wr = wid >> 2, wc = wid & 3, fr = lane & 15, fq = lane >> 4;
    const int K = g.K, nt = K / BK;
    unsigned voffA[2], voffB[2];
#pragma unroll
    for (int i = 0; i < 2; ++i) { int R, C; stage_rc(tid * 16 + i * 8192, R, C); const int Rb = Epi::PERM ? ((R & ~31) + perm32(R & 31)) : R;
        voffA[i] = (unsigned)(R * K + C) * 2u; voffB[i] = (unsigned)(Rb * K + C) * 2u; }
    const size_t kstep = (size_t)(BK * 2);
    const size_t hstep = (size_t)HALF * K * 2;
    const size_t tstep = 2 * hstep;
    const unsigned ldsw = (unsigned)wid * 1024u;
    const int aoff = lds_byte(wr * 64 + fr, fq * 8), boff = lds_byte(wc * 32 + fr, fq * 8);
#define PG8_SA(b, h) (((b) * 2 + (h)) * HTB)
#define PG8_SB(b, h) ((4 + (b) * 2 + (h)) * HTB)
#define PG8_STAGE(bufoff, gbase, voff) do { _Pragma("unroll") for (int _i = 0; _i < 2; ++_i) \
        __builtin_amdgcn_global_load_lds((const unsigned*)((const char*)(gbase) + (voff)[_i]), (PG8_LAS unsigned*)(lds + (bufoff) + ldsw + _i * 8192), 16, 0, 0); } while (0)
#define PG8_LDA(dst, b, h) do { _Pragma("unroll") for (int m = 0; m < 4; ++m) _Pragma("unroll") for (int k = 0; k < 2; ++k) dst[m][k] = *(const PG8_LAS bf16x8*)(lds + PG8_SA(b, h) + aoff + m * 2048 + k * 1024); } while (0)
#define PG8_LDB(dst, b, h) do { _Pragma("unroll") for (int n = 0; n < 2; ++n) _Pragma("unroll") for (int k = 0; k < 2; ++k) dst[n][k] = *(const PG8_LAS bf16x8*)(lds + PG8_SB(b, h) + boff + n * 2048 + k * 1024); } while (0)
#define PG8_MMA(ai, bj, At, Bt) do { __builtin_amdgcn_s_setprio(1); _Pragma("unroll") for (int m = 0; m < 4; ++m) _Pragma("unroll") for (int n = 0; n < 2; ++n) _Pragma("unroll") for (int k = 0; k < 2; ++k) \
        acc[ai][bj][m][n] = __builtin_amdgcn_mfma_f32_16x16x32_bf16(Bt[n][k], At[m][k], acc[ai][bj][m][n], 0, 0, 0); __builtin_amdgcn_s_setprio(0); } while (0)
#define PG8_WAIT_V(n) asm volatile("s_waitcnt vmcnt(" #n ")" ::: "memory")
#define PG8_WAIT_L(n) asm volatile("s_waitcnt lgkmcnt(" #n ")" ::: "memory")
#define PG8_BAR __builtin_amdgcn_s_barrier()
#define PG8_SCHED __builtin_amdgcn_sched_barrier(0)
    Unit cur, nxt; int ui = 0;
    if (!S.next(0, cur)) return;
    f32x4 acc[2][2][4][2];
#pragma unroll
    for (int a = 0; a < 2; ++a)
#pragma unroll
        for (int b = 0; b < 2; ++b)
#pragma unroll
            for (int m = 0; m < 4; ++m)
#pragma unroll
                for (int n = 0; n < 2; ++n) acc[a][b][m][n] = (f32x4){0.f, 0.f, 0.f, 0.f};
    bf16x8 At[4][2], B0[2][2], B1[2][2];
    const char* cA = (const char*)g.A + (size_t)cur.pm * tstep; const char* cB = (const char*)g.Bt + (size_t)cur.pn * tstep;
    S.a_ready(cur);
    if constexpr (SP2) {
        PG8_STAGE(PG8_SB(0, 0), cB, voffB); PG8_STAGE(PG8_SB(0, 1), cB + hstep, voffB); PG8_STAGE(PG8_SA(0, 0), cA, voffA); PG8_STAGE(PG8_SA(0, 1), cA + hstep, voffA);
        if (wr == 1) PG8_BAR;
        PG8_WAIT_V(2); PG8_BAR;
        PG8_STAGE(PG8_SB(1, 0), cB + kstep, voffB); PG8_STAGE(PG8_SA(1, 0), cA + kstep, voffA); PG8_STAGE(PG8_SB(1, 1), cB + hstep + kstep, voffB);
        PG8_WAIT_V(6); PG8_BAR;
    } else {
        PG8_STAGE(PG8_SB(0, 0), cB, voffB); PG8_STAGE(PG8_SA(0, 0), cA, voffA); PG8_STAGE(PG8_SB(0, 1), cB + hstep, voffB); PG8_STAGE(PG8_SA(0, 1), cA + hstep, voffA);
        if (wr == 1) PG8_BAR;
        PG8_WAIT_V(4); PG8_BAR;
        PG8_STAGE(PG8_SB(1, 0), cB + kstep, voffB); PG8_STAGE(PG8_SA(1, 0), cA + kstep, voffA); PG8_STAGE(PG8_SB(1, 1), cB + hstep + kstep, voffB);
        PG8_WAIT_V(6); PG8_BAR;
    }
    for (;;) {
        const bool has_next = S.next(ui + 1, nxt);
        const char* nA = has_next ? (const char*)g.A + (size_t)nxt.pm * tstep : cA; const char* nB = has_next ? (const char*)g.Bt + (size_t)nxt.pn * tstep : cB;
        for (int t = 0; t < nt; t += 2) {
            const bool last = (t == nt - 2);
            const char* a1 = cA + (size_t)(t + 1) * kstep;
            const char* a2 = last ? nA : cA + (size_t)(t + 2) * kstep; const char* b2 = last ? nB : cB + (size_t)(t + 2) * kstep;
            const char* a3 = a2 + kstep; const char* b3 = b2 + kstep;
            if (last && has_next) S.a_ready(nxt);
            if constexpr (SP2) {
            PG8_LDB(B0, 0, 0); PG8_LDB(B1, 0, 1); PG8_SCHED; PG8_LDA(At, 0, 0); PG8_STAGE(PG8_SA(1, 1), a1 + hstep, voffA);
            PG8_WAIT_V(8); PG8_WAIT_L(0); PG8_BAR; PG8_MMA(0, 0, At, B0); PG8_MMA(0, 1, At, B1); PG8_BAR; PG8_SCHED;
            PG8_LDA(At, 0, 1); PG8_STAGE(PG8_SB(0, 0), b2, voffB); PG8_STAGE(PG8_SB(0, 1), b2 + hstep, voffB); PG8_STAGE(PG8_SA(0, 0), a2, voffA);
            PG8_WAIT_V(8); PG8_WAIT_L(0); PG8_BAR; PG8_MMA(1, 0, At, B0); PG8_MMA(1, 1, At, B1); PG8_BAR; PG8_SCHED;
            PG8_LDB(B0, 1, 0); PG8_LDB(B1, 1, 1); PG8_SCHED; PG8_LDA(At, 1, 0); PG8_STAGE(PG8_SA(0, 1), a2 + hstep, voffA);
            PG8_WAIT_V(8); PG8_WAIT_L(0); PG8_BAR; PG8_MMA(0, 0, At, B0); PG8_MMA(0, 1, At, B1); PG8_BAR; PG8_SCHED;
            PG8_LDA(At, 1, 1); PG8_STAGE(PG8_SB(1, 0), b3, voffB); PG8_STAGE(PG8_SB(1, 1), b3 + hstep, voffB); PG8_STAGE(PG8_SA(1, 0), a3, voffA);
            PG8_WAIT_V(8); PG8_WAIT_L(0); PG8_BAR; PG8_MMA(1, 0, At, B0); PG8_MMA(1, 1, At, B1); PG8_BAR; PG8_SCHED;
            } else {
            PG8_LDB(B0, 0, 0); PG8_SCHED; PG8_LDA(At, 0, 0); PG8_STAGE(PG8_SA(1, 1), a1 + hstep, voffA);
            PG8_WAIT_L(8); PG8_BAR; PG8_WAIT_L(0); PG8_MMA(0, 0, At, B0); PG8_BAR; PG8_SCHED;
            PG8_LDB(B1, 0, 1); PG8_STAGE(PG8_SB(0, 0), b2, voffB);
            PG8_BAR; PG8_WAIT_L(0); PG8_MMA(0, 1, At, B1); PG8_BAR;
            PG8_LDA(At, 0, 1); PG8_STAGE(PG8_SA(0, 0), a2, voffA);
            PG8_BAR; PG8_WAIT_L(0); PG8_MMA(1, 0, At, B0); PG8_BAR; PG8_SCHED;
            PG8_STAGE(PG8_SB(0, 1), b2 + hstep, voffB);
            PG8_WAIT_V(6); PG8_BAR; PG8_MMA(1, 1, At, B1); PG8_BAR;
            PG8_LDB(B0, 1, 0); PG8_SCHED; PG8_LDA(At, 1, 0); PG8_STAGE(PG8_SA(0, 1), a2 + hstep, voffA);
            PG8_WAIT_L(8); PG8_BAR; PG8_WAIT_L(0); PG8_MMA(0, 0, At, B0); PG8_BAR; PG8_SCHED;
            PG8_LDB(B1, 1, 1); PG8_STAGE(PG8_SB(1, 0), b3, voffB);
            PG8_BAR; PG8_WAIT_L(0); PG8_MMA(0, 1, At, B1); PG8_BAR;
            PG8_LDA(At, 1, 1); PG8_STAGE(PG8_SA(1, 0), a3, voffA);
            PG8_BAR; PG8_WAIT_L(0); PG8_MMA(1, 0, At, B0); PG8_BAR; PG8_SCHED;
            PG8_STAGE(PG8_SB(1, 1), b3 + hstep, voffB);
            PG8_WAIT_V(6); PG8_BAR; PG8_MMA(1, 1, At, B1); PG8_BAR;
            }
        }
        if constexpr (ALIGN_EPI) { if (wr == 0) PG8_BAR; }
        if constexpr (!Epi::AFTER_DRAIN) { E(acc, cur, wr, wc, fr, fq); S.done(cur); }
        if (!has_next) break;
#pragma unroll
        for (int a = 0; a < 2; ++a)
#pragma unroll
            for (int b = 0; b < 2; ++b)
#pragma unroll
                for (int m = 0; m < 4; ++m)
#pragma unroll
                    for (int n = 0; n < 2; ++n) acc[a][b][m][n] = (f32x4){0.f, 0.f, 0.f, 0.f};
        cur = nxt; cA = nA; cB = nB; ++ui;
        if constexpr (ALIGN_EPI) { if (wr == 1) PG8_BAR; }
    }
    PG8_WAIT_V(0);
    if constexpr (!ALIGN_EPI) { if (wr == 0) PG8_BAR; }
    PG8_BAR;
    if constexpr (Epi::AFTER_DRAIN) { E.fused(acc, cur, wr, wc, fr, fq, lds, wid, lane); S.done(cur); }
#undef PG8_SA
#undef PG8_SB
#undef PG8_STAGE
#undef PG8_LDA
#undef PG8_LDB
#undef PG8_MMA
#undef PG8_WAIT_V
#undef PG8_WAIT_L
#undef PG8_BAR
#undef PG8_SCHED
}
}

#ifndef PG8_SP2
#define PG8_SP2 true
#endif
#ifndef PG8_ALIGN
#define PG8_ALIGN false
#endif
#ifndef PROBE_DUP
#define PROBE_DUP 0
#endif
#ifndef MK_PER_PHASE
#define MK_PER_PHASE 0
#endif

constexpr int NWAVES = 8;
constexpr int BATCH = 4, SEQ = 4096, D = 4096, DEPTH = 4, M = BATCH * SEQ;
constexpr int DFF = 6144, AB_IN = 12288, AB_OUT = 2048, C_IN = 5120, C_OUT = 4096;
constexpr float RMS_EPS = 1e-6f;
constexpr int N_PHASES = 1 + 8 * 3 + 4 * 3 + 1;

constexpr size_t MiB = 1u << 20;
constexpr size_t WS_CTL = 0, CTL_ZERO_BYTES = 1 * MiB;
constexpr size_t WS_WFFI = 1 * MiB;
constexpr size_t WS_WFFO = WS_WFFI + 8 * 96 * MiB;
constexpr size_t WS_WABI = WS_WFFO + 8 * 48 * MiB;
constexpr size_t WS_WABO = WS_WABI + 2 * 96 * MiB;
constexpr size_t WS_WCI  = WS_WABO + 2 * 16 * MiB;
constexpr size_t WS_WCO  = WS_WCI + 2 * 40 * MiB;
constexpr size_t WS_HB   = WS_WCO + 2 * 32 * MiB;
constexpr size_t WS_ACT  = WS_HB + 128 * MiB;
constexpr size_t WS_QKV  = WS_ACT + 192 * MiB;
constexpr size_t WS_AO   = WS_QKV + 384 * MiB;
constexpr size_t WS_PART = WS_AO + 128 * MiB;
constexpr size_t WS_END  = WS_PART + 13 * 4 * MiB;
constexpr int CW_BAR = 4096;

constexpr int RING_OFF = 0, RING_BYTES = 131072;
constexpr int RINV_OFF = RING_BYTES;
constexpr int LDSCTL_OFF = RING_BYTES + 8192, MISC_OFF = LDSCTL_OFF + 320;
constexpr int LDS_BYTES = 147456;
static_assert(MISC_OFF + 128 <= LDS_BYTES, "LDS map");

#define GAS __attribute__((address_space(1)))
#define LAS __attribute__((address_space(3)))
typedef unsigned short bf16;
typedef unsigned v4u __attribute__((ext_vector_type(4)));
typedef float f32x4 __attribute__((ext_vector_type(4)));
#define LDS_WAIT() asm volatile("s_waitcnt lgkmcnt(0)" ::: "memory")
#define VM_WAIT() asm volatile("s_waitcnt vmcnt(0)" ::: "memory")
__device__ __forceinline__ unsigned f2bf(float f) { unsigned u = __builtin_bit_cast(unsigned, f); return (u + 0x7fffu + ((u >> 16) & 1u)) >> 16; }
__device__ __forceinline__ unsigned pk2(float lo, float hi) { unsigned r; asm volatile("v_cvt_pk_bf16_f32 %0, %1, %2" : "=v"(r) : "v"(lo), "v"(hi)); return r; }
__device__ __forceinline__ float bflo(unsigned p) { return __builtin_bit_cast(float, p << 16); }
__device__ __forceinline__ float bfhi(unsigned p) { return __builtin_bit_cast(float, p & 0xffff0000u); }
__device__ __forceinline__ float rdlane_f(float v, int l) { return __builtin_bit_cast(float, __builtin_amdgcn_readlane(__builtin_bit_cast(int, v), l)); }
__device__ __forceinline__ unsigned rdlane_u(unsigned v, int l) { return (unsigned)__builtin_amdgcn_readlane((int)v, l); }
__device__ __forceinline__ float wave_sum(float v) {
#pragma unroll
    for (int o = 1; o < 64; o <<= 1) v += __shfl_xor(v, o);
    return v;
}
__device__ __forceinline__ float wave_max(float v) {
#pragma unroll
    for (int o = 1; o < 64; o <<= 1) v = fmaxf(v, __shfl_xor(v, o));
    return v;
}

#define XB_TMO      128
#define XB_XCNT(j)  (256  + 64 * (j))
#define XB_XSUB(j)  (1280 + 64 * (j))
#define XB_XGEN(j)  (2304 + 64 * (j))
#define XB_TOP      3328
#define XB_TOPGEN   3392
#define XCD_BAR_WORDS 3456
#define XB_SPIN_CAP (1u << 18)

__device__ __forceinline__ unsigned xb_ld(unsigned* p)              { return __hip_atomic_load(p, __ATOMIC_RELAXED, __HIP_MEMORY_SCOPE_AGENT); }
__device__ __forceinline__ unsigned xb_add(unsigned* p, unsigned v) { return __hip_atomic_fetch_add(p, v, __ATOMIC_RELAXED, __HIP_MEMORY_SCOPE_AGENT); }
__device__ __forceinline__ unsigned xb_xcc_id() { return (unsigned)__builtin_amdgcn_s_getreg((3 << 11) | 20) & 0xFu; }
#define XB_SPIN(cond, bar) do { unsigned _sp = 0; while (cond) { __builtin_amdgcn_s_sleep(1); \
    if ((++_sp & 255u) == 0u) { if (xb_ld(&(bar)[XB_TMO])) break; if (_sp > XB_SPIN_CAP) { atomicAdd(&(bar)[XB_TMO], 1u); break; } } } } while (0)

__device__ __forceinline__ int xb_lane_id() { return (int)__builtin_amdgcn_mbcnt_hi(~0u, __builtin_amdgcn_mbcnt_lo(~0u, 0u)); }
struct XcdBarrier {
    unsigned* bar; unsigned x; int w0; unsigned total;
    volatile LAS unsigned* st;
};

__device__ __forceinline__ XcdBarrier xcd_barrier_post(unsigned* bar, volatile LAS unsigned* st, int wave, unsigned total) {
    XcdBarrier b; b.bar = bar; b.x = xb_xcc_id(); b.st = st; b.w0 = (wave == 0); b.total = total;
    if (b.w0 && xb_lane_id() == 0) (void)xb_add(&bar[XB_XCNT(b.x)], 1u);
    return b;
}
__device__ __forceinline__ void xcd_barrier_complete(unsigned* bar, unsigned x, unsigned G, unsigned& nloc, unsigned& nx) {
    unsigned sum, cnt, mine, sp = 0u;
    for (;;) {
        sum = 0u; cnt = 0u; mine = 0u;
#pragma unroll
        for (unsigned j = 0; j < 16; ++j) { const unsigned c = xb_ld(&bar[XB_XCNT(j)]); sum += c; cnt += (c > 0u) ? 1u : 0u; mine = (j == x) ? c : mine; }
        if (sum == G) break;
        __builtin_amdgcn_s_sleep(1);
        if ((++sp & 255u) == 0u) { if (xb_ld(&bar[XB_TMO])) break; if (sp > XB_SPIN_CAP) { atomicAdd(&bar[XB_TMO], 1u); break; } }
    }
    nloc = mine > 0u ? mine : 1u; nx = cnt > 0u ? cnt : 1u;
}

__device__ __forceinline__ void xcd_barrier(const XcdBarrier& b) {
    asm volatile("s_waitcnt vmcnt(0)" ::: "memory");
    __syncthreads();
    if (b.w0 && xb_lane_id() == 0) {
        unsigned* bar = b.bar;
        __builtin_amdgcn_s_waitcnt(0);
        unsigned nloc = b.st[0], nx = b.st[1];
        if (nloc == 0u) { xcd_barrier_complete(bar, b.x, b.total, nloc, nx); b.st[0] = nloc; b.st[1] = nx; }
        const unsigned old = xb_add(&bar[XB_XSUB(b.x)], 1u);
        const unsigned gen = old / nloc;
        if (old + 1u == (gen + 1u) * nloc) {
            __builtin_amdgcn_fence(__ATOMIC_RELEASE, "agent");
            asm volatile("s_waitcnt vmcnt(0)" ::: "memory");
            const unsigned og = xb_add(&bar[XB_TOP], 1u);
            const unsigned tg = og / nx;
            if (og + 1u == (tg + 1u) * nx) xb_add(&bar[XB_TOPGEN], 1u);
            else XB_SPIN(xb_ld(&bar[XB_TOPGEN]) == tg, bar);
            __builtin_amdgcn_fence(__ATOMIC_ACQUIRE, "agent");
            xb_add(&bar[XB_XGEN(b.x)], 1u);
            asm volatile("s_waitcnt vmcnt(0)" ::: "memory");
        } else {
            XB_SPIN(xb_ld(&bar[XB_XGEN(b.x)]) == gen, bar);
            __builtin_amdgcn_fence(__ATOMIC_ACQUIRE, "agent");
            asm volatile("s_waitcnt vmcnt(0)" ::: "memory");
        }
    }
    __syncthreads();
}


__device__ __forceinline__ const float* in_ptr(int k) {
    const __attribute__((address_space(4))) char* p = (const __attribute__((address_space(4))) char*)__builtin_amdgcn_kernarg_segment_ptr();
    asm volatile("" : "+s"(p));
    return *(const float* const __attribute__((address_space(4)))*)(p + 8 * k);
}
struct WDesc { const float* src; bf16* dst; const float* gain; int K, N, mode; };
__device__ __forceinline__ WDesc wdesc(int i, unsigned char* ws) {
    WDesc d;
    if (i < 8) { const int l = i >> 1, w = i & 1; d.src = (w ? in_ptr(11) : in_ptr(2)) + (size_t)l * D * (2 * DFF); d.dst = (bf16*)(ws + WS_WFFI) + (size_t)i * (2 * DFF) * D; d.K = D; d.N = 2 * DFF; d.mode = 1; d.gain = (w ? in_ptr(10) : in_ptr(1)) + (size_t)l * D; }
    else if (i < 16) { const int s = i - 8, l = s >> 1, w = s & 1; d.src = (w ? in_ptr(12) : in_ptr(3)) + (size_t)l * DFF * D; d.dst = (bf16*)(ws + WS_WFFO) + (size_t)s * D * DFF; d.K = DFF; d.N = D; d.mode = 0; d.gain = nullptr; }
    else if (i < 18) { const int e = i - 16; d.src = in_ptr(5) + (size_t)e * D * AB_IN; d.dst = (bf16*)(ws + WS_WABI) + (size_t)e * AB_IN * D; d.K = D; d.N = AB_IN; d.mode = 0; d.gain = in_ptr(4) + (size_t)(2 * e) * D; }
    else if (i < 20) { const int e = i - 18; d.src = in_ptr(6) + (size_t)e * AB_OUT * D; d.dst = (bf16*)(ws + WS_WABO) + (size_t)e * D * AB_OUT; d.K = AB_OUT; d.N = D; d.mode = 0; d.gain = nullptr; }
    else if (i < 22) { const int e = i - 20; d.src = in_ptr(7) + (size_t)e * D * C_IN; d.dst = (bf16*)(ws + WS_WCI) + (size_t)e * C_IN * D; d.K = D; d.N = C_IN; d.mode = 0; d.gain = in_ptr(4) + (size_t)(2 * e + 1) * D; }
    else { const int e = i - 22; d.src = in_ptr(8) + (size_t)e * C_OUT * D; d.dst = (bf16*)(ws + WS_WCO) + (size_t)e * D * C_OUT; d.K = C_OUT; d.N = D; d.mode = 0; d.gain = nullptr; }
    return d;
}
__device__ __forceinline__ void transpose_item(const WDesc& d, LAS float* scr, int item, int lane) {
    const int nblk = d.N / 64, kb = item / nblk, nb = item - kb * nblk, k0 = 64 * kb, n0 = 64 * nb;
    const int l16 = lane & 15, lq = lane >> 4;
#pragma unroll 4
    for (int i = 0; i < 16; ++i) { const int kk = 4 * i + lq; const f32x4 v = *(const f32x4*)(d.src + (size_t)(k0 + kk) * d.N + n0 + 4 * l16);
        LAS float* s = scr + kk * 65 + 4 * l16; s[0] = v[0]; s[1] = v[1]; s[2] = v[2]; s[3] = v[3]; }
    LDS_WAIT(); asm volatile("" ::: "memory");
    const int c = lane & 7;
    f32x4 ga = {1.f, 1.f, 1.f, 1.f}, gb = ga;
    if (d.gain) { ga = *(const f32x4*)(d.gain + k0 + 8 * c); gb = *(const f32x4*)(d.gain + k0 + 8 * c + 4); }
#pragma unroll
    for (int j = 0; j < 8; ++j) { const int n = (lane >> 3) + 8 * j; const LAS float* s = scr + (8 * c) * 65 + n;
        v4u o; o.x = pk2(s[0 * 65] * ga[0], s[1 * 65] * ga[1]); o.y = pk2(s[2 * 65] * ga[2], s[3 * 65] * ga[3]); o.z = pk2(s[4 * 65] * gb[0], s[5 * 65] * gb[1]); o.w = pk2(s[6 * 65] * gb[2], s[7 * 65] * gb[3]);
        int row = n0 + n;
        if (d.mode) { const int up = row >= DFF, jj = row - up * DFF; row = (jj >> 7) * 256 + up * 128 + (jj & 127); }
        *(v4u*)(d.dst + (size_t)row * d.K + k0 + 8 * c) = o; }
    LDS_WAIT(); asm volatile("" ::: "memory");
}
__device__ __forceinline__ void phase_prologue(unsigned char* ws, LAS unsigned char* lds, int gw, int NGW, int wave, int lane) {
    asm volatile("" : "+v"(lane));
    LAS float* scr = (LAS float*)(lds + wave * 16640);
    const int cu = gw / NWAVES, ncu = NGW / NWAVES;
    for (int i = 0; i < 24; ++i) { const WDesc d = wdesc(i, ws); const int nblk = d.N / 64, nsuper = (d.K / 512) * nblk;
        for (int sit = cu; sit < nsuper; sit += ncu) { const int kb8 = sit / nblk, nb = sit - kb8 * nblk; transpose_item(d, scr, (8 * kb8 + wave) * nblk + nb, lane); } }
    const float* x = in_ptr(0); bf16* hb = (bf16*)(ws + WS_HB); float* prt = (float*)(ws + WS_PART);
    for (int row = gw; row < M; row += NGW) {
        const f32x4* xr = (const f32x4*)(x + (size_t)row * D); float sq = 0.f;
#pragma unroll
        for (int j = 0; j < 8; ++j) { const f32x4 a = xr[(lane + 64 * j) * 2], b = xr[(lane + 64 * j) * 2 + 1];
            sq += (a[0] * a[0] + a[1] * a[1]) + (a[2] * a[2] + a[3] * a[3]) + (b[0] * b[0] + b[1] * b[1]) + (b[2] * b[2] + b[3] * b[3]);
            v4u o; o.x = pk2(a[0], a[1]); o.y = pk2(a[2], a[3]); o.z = pk2(b[0], b[1]); o.w = pk2(b[2], b[3]); *((v4u*)(hb + (size_t)row * D) + lane + 64 * j) = o; }
        prt[(size_t)row * 64 + lane] = sq;
    }
}
__device__ __forceinline__ void phase_final_norm(const bf16* xb, const float* g, float* outp, int row0, int rstep, int rend, int lane) {
    asm volatile("" : "+v"(lane));
    for (int row = row0; row < rend; row += rstep) {
        const v4u* xr = (const v4u*)(xb + (size_t)row * D);
        float v[8][8]; float s = 0.f;
#pragma unroll
        for (int j = 0; j < 8; ++j) { const v4u b = xr[lane + 64 * j];
            v[j][0] = bflo(b.x); v[j][1] = bfhi(b.x); v[j][2] = bflo(b.y); v[j][3] = bfhi(b.y); v[j][4] = bflo(b.z); v[j][5] = bfhi(b.z); v[j][6] = bflo(b.w); v[j][7] = bfhi(b.w);
#pragma unroll
            for (int e = 0; e < 8; ++e) s += v[j][e] * v[j][e]; }
        const float r = 1.0f / sqrtf(wave_sum(s) * (1.0f / D) + RMS_EPS);
        const f32x4* gr = (const f32x4*)g;
#pragma unroll
        for (int j = 0; j < 8; ++j) { const f32x4 g0 = gr[(lane + 64 * j) * 2], g1 = gr[(lane + 64 * j) * 2 + 1];
            f32x4 a = {v[j][0], v[j][1], v[j][2], v[j][3]}, b = {v[j][4], v[j][5], v[j][6], v[j][7]};
            f32x4* o = (f32x4*)(outp + (size_t)row * D) + (lane + 64 * j) * 2; o[0] = a * r * g0; o[1] = b * r * g1; }
    }
}
namespace at {
typedef short bf16x8 __attribute__((ext_vector_type(8)));
typedef float f32x16 __attribute__((ext_vector_type(16)));
typedef short s16x4 __attribute__((ext_vector_type(4)));
typedef short v4i16_t __attribute__((ext_vector_type(4)));
typedef float f32x2_t __attribute__((ext_vector_type(2))); typedef __bf16 bf16x2_t __attribute__((ext_vector_type(2)));
#define ATDI __device__ __forceinline__
#define MFMA32(a, b, c) __builtin_amdgcn_mfma_f32_32x32x16_bf16((a), (b), (c), 0, 0, 0)
constexpr float LOG2E = 1.4426950408889634f, LN2 = 0.6931471805599453f;
ATDI unsigned cvtpk(float lo, float hi) { f32x2_t v = {lo, hi}; bf16x2_t b = __builtin_convertvector(v, bf16x2_t); return __builtin_bit_cast(unsigned, b); }
ATDI s16x4 vtr(LAS const char* p) { return __builtin_bit_cast(s16x4, __builtin_amdgcn_ds_read_tr16_b64_v4i16((LAS v4i16_t*)p)); }
ATDI float xmaxh(float v) { const unsigned a = __float_as_uint(v); auto r = __builtin_amdgcn_permlane32_swap(a, a, false, false); return fmaxf(__uint_as_float(r[0]), __uint_as_float(r[1])); }
ATDI float xsumh(float v) { const unsigned a = __float_as_uint(v); auto r = __builtin_amdgcn_permlane32_swap(a, a, false, false); return __uint_as_float(r[0]) + __uint_as_float(r[1]); }
ATDI float xother(float v, int h) { const unsigned a = __float_as_uint(v); auto r = __builtin_amdgcn_permlane32_swap(a, a, false, false); return h ? __uint_as_float(r[0]) : __uint_as_float(r[1]); }
template <int HD> ATDI unsigned voff(unsigned row, unsigned ch) {
    if (HD == 128) return 256u * row + 16u * (ch ^ (((row & 3u) << 2) | ((row >> 2) & 3u)));
    else return 128u * row + 16u * (ch ^ ((((row >> 1) & 1u) << 2) | ((row >> 2) & 3u)));
}
template <int HD> struct State { bf16x8 q[HD / 16]; f32x16 o[HD / 32]; float m, l; };
ATDI unsigned q_loff(int lane, unsigned rstride_bytes) { return (unsigned)(lane & 31) * rstride_bytes + 16u * (unsigned)(lane >> 5); }
template <int HD> ATDI void load_qfrags(bf16x8 (&f)[HD / 16], const char* ubase, unsigned loff) {
#pragma unroll
    for (int s = 0; s < HD / 16; ++s) f[s] = *(const bf16x8*)(ubase + loff + 32 * s);
}
template <int HD> ATDI unsigned v_loff(int lane, unsigned rstride_bytes) { constexpr int CPR = HD / 8; return (unsigned)(lane / CPR) * rstride_bytes + 16u * (unsigned)(lane % CPR); }
template <int HD> ATDI void load_v(v4u (&vr)[HD / 16], const char* ubase, unsigned rstride_bytes, unsigned loff) {
    constexpr int CPR = HD / 8, RPI = 64 / CPR;
#pragma unroll
    for (int i = 0; i < HD / 16; ++i) vr[i] = *(const v4u*)(ubase + (size_t)i * RPI * rstride_bytes + loff);
}
typedef __amdgpu_buffer_rsrc_t rsrc_t;
ATDI rsrc_t make_rsrc(const void* base, unsigned bytes) { return __builtin_amdgcn_make_buffer_rsrc((void*)base, 0, (int)bytes, 0x00020000); }
template <int HD> ATDI void load_vb(v4u (&vr)[HD / 16], rsrc_t rs, unsigned soff, unsigned rstride_bytes, unsigned loff) {
    constexpr int CPR = HD / 8, RPI = 64 / CPR;
#pragma unroll
    for (int i = 0; i < HD / 16; ++i) vr[i] = __builtin_amdgcn_raw_buffer_load_b128(rs, (int)loff, (int)(soff + (unsigned)i * RPI * rstride_bytes), 0);
}
template <int HD> ATDI void store_v(const v4u (&vr)[HD / 16], LAS char* vl, int lane) {
    constexpr int CPR = HD / 8, RPI = 64 / CPR; const int r0 = lane / CPR, ch = lane % CPR;
#pragma unroll
    for (int i = 0; i < HD / 16; ++i) *(LAS v4u*)(vl + voff<HD>((unsigned)(r0 + RPI * i), (unsigned)ch)) = vr[i];
}
template <int HD> ATDI f32x16 qk(LAS const char* kl, const bf16x8 (&qf)[HD / 16], int lane) {
    f32x16 S;
#pragma unroll
    for (int i = 0; i < 16; ++i) S[i] = 0.f;
    const unsigned r = lane & 31, h = lane >> 5;
#pragma unroll
    for (int s = 0; s < HD / 16; ++s) { const bf16x8 kf = *(LAS const bf16x8*)(kl + voff<HD>(r, 2u * s + h)); S = MFMA32(kf, qf[s], S); }
    return S;
}
template <int HD> ATDI void stash_q(LAS char* ql, const char* ubase, unsigned loff, int lane) {
    bf16x8 f[HD / 16]; load_qfrags<HD>(f, ubase, loff);
#pragma unroll
    for (int s = 0; s < HD / 16; ++s) *(LAS bf16x8*)(ql + s * 1024 + lane * 16) = f[s];
}
template <int HD> ATDI f32x16 qk_l(LAS const char* kl, LAS const char* ql, int lane) {
    f32x16 S;
#pragma unroll
    for (int i = 0; i < 16; ++i) S[i] = 0.f;
    const unsigned r = lane & 31, h = lane >> 5;
#pragma unroll
    for (int s = 0; s < HD / 16; ++s) { const bf16x8 kf = *(LAS const bf16x8*)(kl + voff<HD>(r, 2u * s + h)); const bf16x8 qf = *(LAS const bf16x8*)(ql + s * 1024 + lane * 16); S = MFMA32(kf, qf, S); }
    return S;
}
template <int HD> ATDI void pv(f32x16 (&o)[HD / 32], const float (&p)[16], LAS const char* vl, int lane) {
    const unsigned h = lane >> 5, blk = (lane >> 4) & 1, qd = (lane & 15) >> 2, pp = lane & 3;
#pragma unroll
    for (int s = 0; s < 2; ++s) {
        bf16x8 pf; { unsigned w[4];
#pragma unroll
            for (int j = 0; j < 4; ++j) w[j] = cvtpk(p[8 * s + 2 * j], p[8 * s + 2 * j + 1]);
            typedef unsigned u4 __attribute__((ext_vector_type(4))); u4 ww = {w[0], w[1], w[2], w[3]}; pf = __builtin_bit_cast(bf16x8, ww); }
#pragma unroll
        for (int db = 0; db < HD / 32; ++db) {
            const unsigned ch = 4 * db + 2 * blk + (pp >> 1);
            const s16x4 lo = vtr(vl + voff<HD>(16 * s + 4 * h + qd, ch) + 8 * (pp & 1));
            const s16x4 hi = vtr(vl + voff<HD>(16 * s + 8 + 4 * h + qd, ch) + 8 * (pp & 1));
            const bf16x8 vf = __builtin_shufflevector(lo, hi, 0, 1, 2, 3, 4, 5, 6, 7);
            o[db] = MFMA32(vf, pf, o[db]);
        }
    }
}
template <int HD> ATDI void band_tile(State<HD>& st, const f32x16& S, LAS const char* vl, int lane, int dl, float c1, float c2, int maxd, bool need_mask) {
    const f32x16 KROV = {0.f, 1.f, 2.f, 3.f, 8.f, 9.f, 10.f, 11.f, 16.f, 17.f, 18.f, 19.f, 24.f, 25.f, 26.f, 27.f};
    const float b0 = -c2 * (float)dl;
    f32x16 sc = S * c1 + (KROV * c2 + b0);
    if (need_mask) {
#pragma unroll
        for (int v = 0; v < 16; ++v) { const int kro = (v & 3) + 8 * (v >> 2); sc[v] = ((unsigned)(dl - kro) <= (unsigned)maxd) ? sc[v] : -INFINITY; }
    }
    float tmax = fmaxf(fmaxf(sc[0], sc[1]), fmaxf(sc[2], sc[3]));
#pragma unroll
    for (int v = 4; v < 16; v += 4) tmax = fmaxf(tmax, fmaxf(fmaxf(sc[v], sc[v + 1]), fmaxf(sc[v + 2], sc[v + 3])));
    tmax = xmaxh(tmax);
    if (__any(tmax > st.m)) {
        const float mnew = fmaxf(st.m, tmax), alpha = __builtin_amdgcn_exp2f(st.m - mnew); st.m = mnew; st.l *= alpha;
#pragma unroll
        for (int db = 0; db < HD / 32; ++db) st.o[db] = st.o[db] * alpha;
    }
    sc = sc - st.m;
    float p[16]; float ps = 0.f;
#pragma unroll
    for (int v = 0; v < 16; ++v) { p[v] = __builtin_amdgcn_exp2f(sc[v]); ps += p[v]; }
    st.l += ps;
    pv<HD>(st.o, p, vl, lane);
}
template <int HD> ATDI void sb_tile(State<HD>& st, const f32x16& S, LAS const char* vl, int lane, bool diag, float scale2  , float& P) {
    const int q = lane & 31, h = lane >> 5;
    float p[16], seg[4];
#pragma unroll
    for (int a = 0; a < 4; ++a) { float run = 1.f;
#pragma unroll
        for (int j = 3; j >= 0; --j) { const int v = 4 * a + j, kro = j + 8 * a + 4 * h;
            const float z = S[v] * scale2, e = __builtin_amdgcn_exp2f(-fabsf(z)), r = __builtin_amdgcn_rcpf(1.0f + e), er = e * r;
            float sig = z >= 0.f ? r : er, keep = z >= 0.f ? er : r;
            if (diag && !(kro < q)) { sig = 0.f; keep = 1.f; }
            p[v] = sig * run; run *= keep; }
        seg[a] = run; }
    float ps[4], T[4];
#pragma unroll
    for (int a = 0; a < 4; ++a) { ps[a] = xother(seg[a], h); T[a] = seg[a] * ps[a]; }
    float aft[4]; aft[3] = 1.f; aft[2] = T[3]; aft[1] = T[3] * T[2]; aft[0] = aft[1] * T[1];
    const float total = aft[0] * T[0];
#pragma unroll
    for (int a = 0; a < 4; ++a) { const float off = aft[a] * (h == 0 ? ps[a] : 1.f) * P;
#pragma unroll
        for (int j = 0; j < 4; ++j) p[4 * a + j] *= off; }
    P *= total;
    pv<HD>(st.o, p, vl, lane);
}
template <int HD> ATDI void store_out(const State<HD>& st, float inv, bf16* orow, int h) {
#pragma unroll
    for (int db = 0; db < HD / 32; ++db)
#pragma unroll
        for (int g = 0; g < 4; ++g) { typedef unsigned u2 __attribute__((ext_vector_type(2)));
            u2 w; w.x = cvtpk(st.o[db][4 * g] * inv, st.o[db][4 * g + 1] * inv); w.y = cvtpk(st.o[db][4 * g + 2] * inv, st.o[db][4 * g + 3] * inv);
            *(u2*)(orow + 32 * db + 8 * g + 4 * h) = w; }
}
template <int HD> ATDI unsigned ost_off(unsigned row, unsigned chunk) { constexpr unsigned CPR = HD / 8; return row * (HD * 2) + 16u * (chunk ^ (row & (CPR - 1))); }
template <int HD> ATDI void stage_rows_out(LAS char* stg, rsrc_t ors, unsigned soff, unsigned rstride_bytes, int lane) {
    constexpr int CPR = HD / 8, RPI = 64 / CPR; const unsigned r0 = lane / CPR, cc = lane % CPR, voff_ = r0 * rstride_bytes + 16u * cc;
#pragma unroll
    for (int i = 0; i < HD / 16; ++i) { const v4u v = *(LAS const v4u*)(stg + ost_off<HD>(r0 + RPI * i, cc)); __builtin_amdgcn_raw_buffer_store_b128(v, ors, (int)voff_, (int)(soff + (unsigned)i * RPI * rstride_bytes), 0); }
}
template <int HD> ATDI void stage_rows_in(LAS char* stg, rsrc_t ors, unsigned soff, unsigned rstride_bytes, int lane) {
    constexpr int CPR = HD / 8, RPI = 64 / CPR; const unsigned r0 = lane / CPR, cc = lane % CPR, voff_ = r0 * rstride_bytes + 16u * cc;
#pragma unroll
    for (int ib = 0; ib < HD / 16; ib += 4) {
        v4u v[4];
#pragma unroll
        for (int i = 0; i < 4; ++i) v[i] = __builtin_amdgcn_raw_buffer_load_b128(ors, (int)voff_, (int)(soff + (unsigned)(ib + i) * RPI * rstride_bytes), 0);
#pragma unroll
        for (int i = 0; i < 4; ++i) *(LAS v4u*)(stg + ost_off<HD>(r0 + RPI * (ib + i), cc)) = v[i];
        asm volatile("" ::: "memory");
    }
}
template <int HD> ATDI void store_out_rows(const State<HD>& st, float inv, LAS char* stg, rsrc_t ors, unsigned soff, unsigned rstride_bytes, int lane) {
    const unsigned q = lane & 31, h = lane >> 5; typedef unsigned u2 __attribute__((ext_vector_type(2)));
#pragma unroll
    for (int db = 0; db < HD / 32; ++db)
#pragma unroll
        for (int g = 0; g < 4; ++g) { u2 w; w.x = cvtpk(st.o[db][4 * g] * inv, st.o[db][4 * g + 1] * inv); w.y = cvtpk(st.o[db][4 * g + 2] * inv, st.o[db][4 * g + 3] * inv);
            *(LAS u2*)(stg + ost_off<HD>(q, 4 * db + g) + 8 * h) = w; }
    stage_rows_out<HD>(stg, ors, soff, rstride_bytes, lane);
}
template <int HD> ATDI void zero_o(State<HD>& st) {
#pragma unroll
    for (int db = 0; db < HD / 32; ++db)
#pragma unroll
        for (int i = 0; i < 16; ++i) st.o[db][i] = 0.f;
}

struct CPos { int u, kt; };
ATDI int c_ktlo(int u) { const int qt = u & 127; return qt - 4 > 0 ? qt - 4 : 0; }
ATDI CPos c_next(CPos p, int G) { CPos n; if (p.kt > c_ktlo(p.u)) { n.u = p.u; n.kt = p.kt - 1; } else { n.u = p.u + G; n.kt = n.u & 127; } return n; }
ATDI const char* c_tile(const bf16* qkv, CPos p) { const int hk = (p.u >> 7) & 7, b = p.u >> 10; return (const char*)(qkv + ((size_t)(64 + hk) * M + (size_t)b * SEQ + 32 * p.kt) * 64); }
ATDI const char* c_qrow(const bf16* qkv, int u, int wave) { const int qt = u & 127, hk = (u >> 7) & 7, b = u >> 10; return (const char*)(qkv + ((size_t)(8 * hk + wave) * M + (size_t)b * SEQ + 32 * qt) * 64); }
template <int MODE = 0> ATDI void phase_attn_c(const bf16* qkv, const float* sinks, bf16* ao, LAS unsigned char* lds, int vcu  , int G  , int C_NU  , int wave, int lane) {
    asm volatile("" : "+v"(lane));
    constexpr int HD = 64;
    const int q = lane & 31, h = lane >> 5;
    const unsigned qloff = q_loff(lane, 128);
    const int isv = wave >> 2, idx = 64 * (wave & 3) + lane, prow = idx >> 3, pch = idx & 7;
    const unsigned src_off = (unsigned)prow * 128u + 16u * (unsigned)pch + (isv ? (unsigned)((size_t)8 * M * 128) : 0u);
    const unsigned dst_off = (isv ? 4096u : 0u) + voff<HD>((unsigned)prow, (unsigned)pch);
    const float c1 = 0.125f * LOG2E;
    const rsrc_t ors = make_rsrc(ao, (unsigned)((size_t)M * C_OUT * 2));
    if (vcu >= C_NU) return;
    State<HD> st; float c2 = 0.f; bf16x8 qn[4];
    CPos p0; p0.u = vcu; p0.kt = vcu & 127; CPos p1 = c_next(p0, G);
    v4u r = *(const v4u*)(c_tile(qkv, p0) + src_off);
    *(LAS v4u*)((LAS char*)lds + dst_off) = r;
    r = *(const v4u*)(c_tile(qkv, p1.u < C_NU ? p1 : p0) + src_off);
    load_qfrags<HD>(qn, c_qrow(qkv, p0.u, wave), qloff);
    asm volatile("s_waitcnt lgkmcnt(0)" ::: "memory"); __builtin_amdgcn_s_barrier(); asm volatile("" ::: "memory");
    for (int t = 0; p0.u < C_NU; ++t) {
        const int ln = lane;
        LAS char* cur = (LAS char*)lds + (t & 1) * 8192; LAS char* nxt = (LAS char*)lds + ((t + 1) & 1) * 8192;
        const CPos p2 = c_next(p1, G);
        const int qt = p0.u & 127, hq = __builtin_amdgcn_readfirstlane(8 * ((p0.u >> 7) & 7) + wave);
        *(LAS v4u*)(nxt + dst_off) = r;
        if (MODE != 2) r = *(const v4u*)(c_tile(qkv, p2.u < C_NU ? p2 : p0) + src_off);
        if (p0.kt == qt) {
#pragma unroll
            for (int s_ = 0; s_ < 4; ++s_) st.q[s_] = qn[s_];
            const float sk = sinks[hq];
            zero_o<HD>(st); st.m = sk * LOG2E; st.l = (h == 0) ? 1.0f : 0.0f; c2 = __builtin_amdgcn_exp2f(-(float)(hq + 1) * 0.125f) * LOG2E;
            const int un = p0.u + G; load_qfrags<HD>(qn, c_qrow(qkv, un < C_NU ? un : p0.u, wave), qloff);
        }
        if (MODE != 1) { const f32x16 S = qk<HD>(cur, st.q, ln);
        band_tile<HD>(st, S, cur + 4096, ln, 32 * (qt - p0.kt) + q - 4 * h, c1, c2, 127, (p0.kt == qt) || (qt - p0.kt == 4)); }
        if (MODE != 3 && p0.kt == c_ktlo(p0.u)) { const float l = xsumh(st.l); int lo_ = lane; asm volatile("" : "+v"(lo_));
            store_out_rows<HD>(st, 1.0f / l, (LAS char*)lds + 16384 + wave * 4096, ors, (unsigned)((((size_t)(p0.u >> 10) * SEQ + 32 * qt) * C_OUT + hq * 64) * 2), C_OUT * 2, lo_); }
        asm volatile("s_waitcnt lgkmcnt(0)" ::: "memory"); __builtin_amdgcn_s_barrier(); asm volatile("" ::: "memory");
        p0 = p1; p1 = p2;
    }
}
template <int HD> ATDI void a_pass(State<HD>& st, const char* qbase, unsigned qloff, rsrc_t rs, unsigned kb  , unsigned vofs  , unsigned rsb, int Q0, int qstep, float c2,
                                   LAS char* kl  , LAS char* vl  , int lane) {
    const int q = lane & 31, h = lane >> 5;
    const float c1 = 0.08838834764831845f * LOG2E;
    load_qfrags<HD>(st.q, qbase, qloff);
    int kt_lo = (Q0 - 128) >> 5; if (kt_lo < 0) kt_lo = 0; const int kt_hi = (Q0 + 31 * qstep) >> 5;
    const unsigned vloff = v_loff<HD>(lane, rsb);
    v4u kr[HD / 16], vr[HD / 16];
    load_vb<HD>(kr, rs, kb + (unsigned)(32 * kt_hi) * rsb, rsb, vloff); load_vb<HD>(vr, rs, kb + vofs + (unsigned)(32 * kt_hi) * rsb, rsb, vloff);
    for (int kt = kt_hi; kt >= kt_lo; --kt) {
        int ln = lane; asm volatile("" : "+v"(ln));
        float c2t = c2; asm volatile("" : "+v"(c2t));
        store_v<HD>(kr, kl, ln); store_v<HD>(vr, vl, ln);
        if (kt > kt_lo) { load_vb<HD>(kr, rs, kb + (unsigned)(32 * (kt - 1)) * rsb, rsb, vloff); load_vb<HD>(vr, rs, kb + vofs + (unsigned)(32 * (kt - 1)) * rsb, rsb, vloff); }
        const f32x16 S = qk<HD>(kl, st.q, ln);
        const int D0 = Q0 - 32 * kt; band_tile<HD>(st, S, vl, ln, D0 + qstep * q - 4 * h, c1, c2t, 128, (D0 < 31) || (D0 + 31 * qstep > 128));
    }
}
ATDI float a_slope2(int head, int r) { return __builtin_amdgcn_exp2f(-(float)(head + 1) * (1.0f / 3.0f)) * (float)r * LOG2E; }
ATDI void phase_attn_a(const bf16* qkv, bf16* ao, LAS unsigned char* lds, int vcu, int G, int wave, int lane) {
    asm volatile("" : "+v"(lane));
    constexpr int HD = 128; LAS char* kl = (LAS char*)lds + wave * 16384; LAS char* vl = kl + 8192;
    typedef float f32x2v __attribute__((ext_vector_type(2)));
    LAS f32x2v* ML = (LAS f32x2v*)((LAS char*)lds + 131072);
    const int q = lane & 31, h = lane >> 5;
    const rsrc_t rs = make_rsrc(qkv, (unsigned)((size_t)M * AB_IN * 2));
    constexpr unsigned AVOFS = (unsigned)((size_t)24 * M * 256);
    for (int wgu = vcu; wgu < BATCH * 8 * 8; wgu += G) {
        const int ch = wgu & 7, hs = (wgu >> 3) & 7, b = wgu >> 6;
        const size_t tokb = (size_t)b * SEQ;
#pragma unroll 1
        for (int bi = 0; bi < 2; ++bi) {
            const int blk = wave + 8 * bi, T0 = 512 * ch + 32 * blk;
            State<HD> st; zero_o<HD>(st); st.m = -1e30f; st.l = 0.f;
            a_pass<HD>(st, (const char*)(qkv + ((size_t)hs * M + tokb + T0) * 128), q_loff(lane, 256), rs, (unsigned)((((size_t)(24 + hs)) * M + tokb) * 256), AVOFS, 256u, T0, 1, a_slope2(hs, 1), kl, vl, lane);
            const float l0 = xsumh(st.l);
            store_out<HD>(st, 1.0f, ao + (tokb + T0 + q) * AB_OUT + hs * 128, h);
            if (h == 0) ML[32 * blk + q] = (f32x2v){st.m, l0};
        }
        asm volatile("s_waitcnt vmcnt(0)" ::: "memory"); __syncthreads();
#pragma unroll 1
        for (int ci = 0; ci < 2; ++ci) {
            const int c = wave + 8 * ci, tq0 = 512 * ch + c;
            State<HD> st; zero_o<HD>(st); st.m = -1e30f; st.l = 0.f;
            const unsigned qloff = q_loff(lane, 16 * 256);
#pragma unroll 1
            for (int g = 1; g < 3; ++g) { const int head = 8 * g + hs, sh = 2 * g, r = 1 << sh, cr = c & (r - 1);
                a_pass<HD>(st, (const char*)(qkv + ((size_t)head * M + tokb + tq0) * 128), qloff, rs, (unsigned)((((size_t)(24 + head)) * M + tokb + cr) * 256), AVOFS, (unsigned)r * 256u,
                           (512 >> sh) * ch + (c >> sh), 16 >> sh, a_slope2(head, r), kl, vl, lane); }
            const float l12 = xsumh(st.l);
            const f32x2v ml = ML[c + 16 * q];
            const float mt = fmaxf(st.m, ml.x), a12 = __builtin_amdgcn_exp2f(st.m - mt), a0 = __builtin_amdgcn_exp2f(ml.x - mt);
            const float inv = 1.0f / (l12 * a12 + ml.y * a0), w12 = a12 * inv, w0 = a0 * inv;
            bf16* orow = ao + (tokb + tq0 + 16 * q) * AB_OUT + hs * 128;
#pragma unroll
            for (int db = 0; db < HD / 32; ++db)
#pragma unroll
                for (int g4 = 0; g4 < 4; ++g4) { typedef unsigned u2 __attribute__((ext_vector_type(2)));
                    u2* p = (u2*)(orow + 32 * db + 8 * g4 + 4 * h); const u2 o0 = *p;
                    const float r0 = st.o[db][4 * g4] * w12 + bflo(o0.x) * w0, r1 = st.o[db][4 * g4 + 1] * w12 + bfhi(o0.x) * w0;
                    const float r2 = st.o[db][4 * g4 + 2] * w12 + bflo(o0.y) * w0, r3 = st.o[db][4 * g4 + 3] * w12 + bfhi(o0.y) * w0;
                    u2 w; w.x = cvtpk(r0, r1); w.y = cvtpk(r2, r3); *p = w; }
        }
        asm volatile("s_waitcnt vmcnt(0)" ::: "memory"); __syncthreads();
    }
}
ATDI void phase_attn_b(const bf16* qkv, bf16* ao, LAS unsigned char* lds, int wu0, int wstep, int wend, int wave, int lane) {
    asm volatile("" : "+v"(lane));
    constexpr int HD = 128; LAS char* kvl = (LAS char*)lds + wave * 16384; LAS char* ql = kvl + 8192;
    const int q = lane & 31, h = lane >> 5;
    const unsigned qloff = q_loff(lane, 256), vloff = v_loff<HD>(lane, 256);
    const rsrc_t rs = make_rsrc(qkv, (unsigned)((size_t)M * AB_IN * 2));
    const rsrc_t ors = make_rsrc(ao, (unsigned)((size_t)M * AB_OUT * 2));
    constexpr unsigned BVOFS = (unsigned)((size_t)8 * M * 256);
    for (int wu = wu0; wu < wend; wu += wstep) {
        const int qt = wu & 127, hs = (wu >> 7) & 7, b = wu >> 10;
        const size_t tokb = (size_t)b * SEQ;
        State<HD> st; zero_o<HD>(st); stash_q<HD>(ql, (const char*)(qkv + ((size_t)(72 + hs) * M + tokb + 32 * qt) * 128), qloff, lane);
        float P = 1.f;
        const unsigned kb = (unsigned)(((size_t)(80 + hs) * M + tokb) * 256);
        v4u kr[HD / 16], vr[HD / 16];
        load_vb<HD>(kr, rs, kb + (unsigned)(32 * qt) * 256u, 256u, vloff); load_vb<HD>(vr, rs, kb + BVOFS + (unsigned)(32 * qt) * 256u, 256u, vloff);
        for (int kt = qt; kt >= 0; --kt) {
            store_v<HD>(kr, kvl, lane);
            if (kt > 0) load_vb<HD>(kr, rs, kb + (unsigned)(32 * (kt - 1)) * 256u, 256u, vloff);
            const f32x16 S = qk_l<HD>(kvl, ql, lane);
            store_v<HD>(vr, kvl, lane);
            if (kt > 0) load_vb<HD>(vr, rs, kb + BVOFS + (unsigned)(32 * (kt - 1)) * 256u, 256u, vloff);
            sb_tile<HD>(st, S, kvl, lane, kt == qt, 0.08838834764831845f * LOG2E, P);
            if (__all(P < 1e-37f)) break;
        }
        store_out_rows<HD>(st, 1.0f, kvl, ors, (unsigned)(((tokb + 32 * qt) * AB_OUT + 1024 + hs * 128) * 2), AB_OUT * 2, lane);
    }
}
}


struct Args { const float* in[14]; float* out; unsigned char* ws; int ph_lo, ph_hi, li, pad; };
constexpr int GRP_WGS = 64, GRID_WGS = 4 * GRP_WGS;
__global__ void __launch_bounds__(NWAVES * 64, 2) fwd_kernel(Args args) {
    extern __shared__ __attribute__((aligned(16))) unsigned char lds_raw[];
    LAS unsigned char* lds = (LAS unsigned char*)lds_raw;
    volatile LAS unsigned* MISC = (volatile LAS unsigned*)(lds + MISC_OFF);
    const int wave = __builtin_amdgcn_readfirstlane((int)threadIdx.x >> 6);
#define LANE_ID() ((int)__builtin_amdgcn_mbcnt_hi(~0u, __builtin_amdgcn_mbcnt_lo(~0u, 0u)))
    const int G = gridDim.x, bx = blockIdx.x, vcu = (bx % 8) * (G / 8) + bx / 8;
    const int gw = vcu * NWAVES + wave, NGW = G * NWAVES;
    const int bb = (bx & 7) >> 1, xl = bx & 1, cl = bx >> 3, gci = xl * 32 + cl;
    unsigned char* ws = args.ws;
    unsigned* ctl = (unsigned*)(ws + WS_CTL);
    for (int u = wave * 64 + LANE_ID(); u < (LDS_BYTES - LDSCTL_OFF) / 4; u += NWAVES * 64) ((LAS unsigned*)(lds + LDSCTL_OFF))[u] = 0u;
    __syncthreads();
    const XcdBarrier bar0 = xcd_barrier_post(ctl + CW_BAR, MISC + 8, wave, (unsigned)G);
    const XcdBarrier bar = xcd_barrier_post(ctl + CW_BAR + (1 + bb) * XCD_BAR_WORDS, MISC + 12, wave, (unsigned)GRP_WGS);

    bf16* HB = (bf16*)(ws + WS_HB); bf16* ACT = (bf16*)(ws + WS_ACT); bf16* QKV = (bf16*)(ws + WS_QKV); bf16* AO = (bf16*)(ws + WS_AO);

    phase_prologue(ws, lds, gw, NGW, wave, LANE_ID());
    xcd_barrier(bar0);

    float* PART = (float*)(ws + WS_PART);
    LAS float* rtab = (LAS float*)(lds + RINV_OFF);
    int rs = 0;
#pragma unroll 1
    for (int s = 0; s < 8; ++s) {
        const int l = s >> 1, second = s & 1;
        { pg8::Gemm g{HB, (const bf16*)(ws + WS_WFFI) + (size_t)s * (2 * DFF) * D, M, 2 * DFF, D}; pg8::GroupOrder S; S.init(2 * DFF, 16 * bb + 8 * xl, cl, wave);
          const float* prt = PART + (size_t)rs * M * 64; pg8::rinv_panel(prt, S.pm0, rtab, wave); if (S.mode8) pg8::rinv_panel(prt, S.pm0 + 4, rtab + 256, wave);
          pg8::EpiSwiglu E{ACT, DFF, pg8::RowScale{rtab, S.pm0, prt}};
          pg8::gemm_phase<pg8::EpiSwiglu, pg8::GroupOrder, PG8_ALIGN, PG8_SP2>(lds + RING_OFF, g, S, E); }
        xcd_barrier(bar);
        { pg8::Gemm g{ACT, (const bf16*)(ws + WS_WFFO) + (size_t)s * D * DFF, M, D, DFF}; pg8::GroupOrder S; S.init(D, 16 * bb + 8 * xl, cl, wave);
          pg8::EpiResid E{HB, PART + (size_t)(rs + 1) * M * 64, D, 0.5f};
          pg8::gemm_phase<pg8::EpiResid, pg8::GroupOrder, PG8_ALIGN, PG8_SP2>(lds + RING_OFF, g, S, E); }
        xcd_barrier(bar);
        ++rs;
        if (second && s != 7) xcd_barrier(bar0);
        if (!second) {
            const int e = l >> 1, isC = l & 1;
            { const int N = isC ? C_IN : AB_IN;
              const bf16* Wt = isC ? (const bf16*)(ws + WS_WCI) + (size_t)e * C_IN * D : (const bf16*)(ws + WS_WABI) + (size_t)e * AB_IN * D;
              pg8::Gemm g{HB, Wt, M, N, D}; pg8::GroupOrder S; S.init(N, 16 * bb + 8 * xl, cl, wave);
              const float* prt = PART + (size_t)rs * M * 64; pg8::rinv_panel(prt, S.pm0, rtab, wave); if (S.mode8) pg8::rinv_panel(prt, S.pm0 + 4, rtab + 256, wave);
              if (isC) { pg8::EpiHeads<64> E{QKV, M, pg8::RowScale{rtab, S.pm0, prt}}; pg8::gemm_phase<pg8::EpiHeads<64>, pg8::GroupOrder, PG8_ALIGN, PG8_SP2>(lds + RING_OFF, g, S, E); }
              else { pg8::EpiHeads<128> E{QKV, M, pg8::RowScale{rtab, S.pm0, prt}}; pg8::gemm_phase<pg8::EpiHeads<128>, pg8::GroupOrder, PG8_ALIGN, PG8_SP2>(lds + RING_OFF, g, S, E); } }
            xcd_barrier(bar);
            if (isC) at::phase_attn_c<0>(QKV, in_ptr(9) + e * 64, AO, lds, bb * 1024 + gci, GRP_WGS, (bb + 1) * 1024, wave, LANE_ID());
            else { at::phase_attn_a(QKV, AO, lds, bb * 64 + gci, GRID_WGS, wave, LANE_ID());
                   at::phase_attn_b(QKV, AO, lds, bb * 1024 + gci * NWAVES + wave, GRP_WGS * NWAVES, (bb + 1) * 1024, wave, LANE_ID()); }
            xcd_barrier(bar);
            { const int K = isC ? C_OUT : AB_OUT;
              const bf16* Wt = isC ? (const bf16*)(ws + WS_WCO) + (size_t)e * D * C_OUT : (const bf16*)(ws + WS_WABO) + (size_t)e * D * AB_OUT;
              pg8::Gemm g{AO, Wt, M, D, K}; pg8::GroupOrder S; S.init(D, 16 * bb + 8 * xl, cl, wave);
              pg8::EpiResid E{HB, PART + (size_t)(rs + 1) * M * 64, D, 1.0f};
              pg8::gemm_phase<pg8::EpiResid, pg8::GroupOrder, PG8_ALIGN, PG8_SP2>(lds + RING_OFF, g, S, E); }
            xcd_barrier(bar);
            ++rs;
        }
    }
    phase_final_norm(HB, in_ptr(13), (float*)in_ptr(14), bb * SEQ + gci * NWAVES + wave, GRP_WGS * NWAVES, (bb + 1) * SEQ, LANE_ID());
#undef LANE_ID
}

extern "C" void kernel_launch(void* const* d_in, const int* in_sizes, int n_in, void* d_out, int out_size, void* d_ws, size_t ws_size, hipStream_t stream) {
    static int grid = 0;
    if (grid == 0) {
        if (n_in != 14 || in_sizes[0] != M * D || out_size != M * D || ws_size < WS_END) { fprintf(stderr, "kernel_launch: unexpected shapes (n_in %d, in0 %d, out %d, ws %zu < %zu); nothing launched\n", n_in, n_in > 0 ? in_sizes[0] : -1, out_size, ws_size, (size_t)WS_END); grid = -1; return; }
        int dev = 0, cus = 0, per_cu = 0;
        if (hipGetDevice(&dev) != hipSuccess || hipDeviceGetAttribute(&cus, hipDeviceAttributeMultiprocessorCount, dev) != hipSuccess) { fprintf(stderr, "kernel_launch: device query failed\n"); grid = -1; return; }
        if (hipFuncSetAttribute((const void*)fwd_kernel, hipFuncAttributeMaxDynamicSharedMemorySize, LDS_BYTES) != hipSuccess) { fprintf(stderr, "kernel_launch: hipFuncSetAttribute failed\n"); grid = -1; return; }
        if (hipOccupancyMaxActiveBlocksPerMultiprocessor(&per_cu, (const void*)fwd_kernel, NWAVES * 64, LDS_BYTES) != hipSuccess || per_cu < 1) fprintf(stderr, "kernel_launch: note: occupancy query reports %d workgroups per CU\n", per_cu);
        (void)hipGetLastError();
        if (cus != GRID_WGS) { fprintf(stderr, "kernel_launch: this kernel is laid out for %d CUs with one resident workgroup each (found %d CUs, %d workgroups per CU); nothing launched\n", GRID_WGS, cus, per_cu); grid = -1; return; }
        grid = GRID_WGS;
    }
    if (grid < 0) return;
    if (hipMemsetAsync((char*)d_ws + WS_CTL, 0, CTL_ZERO_BYTES, stream) != hipSuccess) { fprintf(stderr, "kernel_launch: memset failed\n"); return; }
    Args a{};
    for (int i = 0; i < 14; ++i) a.in[i] = (const float*)d_in[i];
    a.out = (float*)d_out; a.ws = (unsigned char*)d_ws;
    a.ph_lo = 0; a.ph_hi = N_PHASES; a.li = 0;
    hipLaunchKernelGGL(fwd_kernel, dim3(grid), dim3(NWAVES * 64), LDS_BYTES, stream, a);
    const hipError_t le = hipPeekAtLastError();
    if (le != hipSuccess) fprintf(stderr, "kernel_launch: launch failed: %s\n", hipGetErrorName(le));
}
```
